# Optimizing an MI355X kernel written in HIP

```python
import math
import jax
import jax.numpy as jnp
from jax import lax
import numpy as np

D_MODEL = 1024
BATCH = 8
SEQ = 4096
DEPTH = 2

N_A_LAYERS = DEPTH // 2
N_B_LAYERS = DEPTH - N_A_LAYERS
N_DENSE_FFN = (DEPTH + 1) // 2
N_MOE_FFN = DEPTH // 2

D_RNN = D_MODEL
RNN_BLOCKS = 8
RNN_BLOCK_W = D_RNN // RNN_BLOCKS
CONV_W = 4
LRU_C = 8.0

MEM_TOKENS = 256
MEM_HEADS = 4
MEM_HEAD_DIM = D_MODEL // 8
MEM_W = MEM_HEADS * MEM_HEAD_DIM

DIFF_HEADS = 8
DIFF_HEAD_DIM = D_MODEL // 16
DIFF_V_DIM = 2 * DIFF_HEAD_DIM
DIFF_QK_W = DIFF_HEADS * 2 * DIFF_HEAD_DIM
DIFF_V_W = DIFF_HEADS * DIFF_V_DIM
Q_BLOCK = 128

FFN_DIM = (7 * D_MODEL) // 2
N_EXPERTS = 8
TOP_K = 2
EXPERT_DIM = FFN_DIM
MOE_BLOCK = 256

LN_EPS = 1e-5
DEEPNORM_ALPHA = (2.0 * DEPTH) ** 0.25
DEEPNORM_BETA = (8.0 * DEPTH) ** -0.25

kernel_name = "yoco_rglru_diffattn_moe_deepnorm"


def layer_norm(x, g, b):
    xf = x.astype(jnp.float32)
    mu = jnp.mean(xf, -1, keepdims=True)
    var = jnp.mean(jnp.square(xf - mu), -1, keepdims=True)
    return ((xf - mu) * lax.rsqrt(var + LN_EPS) * g + b).astype(x.dtype)


def rms_norm(x, g):
    xf = x.astype(jnp.float32)
    return (xf * lax.rsqrt(jnp.mean(jnp.square(xf), -1, keepdims=True) + LN_EPS) * g).astype(x.dtype)


def memory_attention(q, mem, w_mem_kv):
    B, T, _ = q.shape
    kv = mem @ w_mem_kv
    k = kv[..., :MEM_W].reshape(B, -1, MEM_HEADS, MEM_HEAD_DIM)
    v = kv[..., MEM_W:].reshape(B, -1, MEM_HEADS, MEM_HEAD_DIM)
    qh = q.reshape(B, T, MEM_HEADS, MEM_HEAD_DIM)
    s = jnp.einsum('bthd,bmhd->bhtm', qh, k).astype(jnp.float32) * (MEM_HEAD_DIM ** -0.5)
    p = jax.nn.softmax(s, axis=-1).astype(v.dtype)
    o = jnp.einsum('bhtm,bmhd->bthd', p, v)
    return o.reshape(B, T, MEM_W)


def causal_depthwise_conv(u, w, b):
    out = lax.conv_general_dilated(
        u, w[:, None, :], window_strides=(1,), padding=[(CONV_W - 1, 0)],
        dimension_numbers=('NWC', 'WIO', 'NWC'), feature_group_count=u.shape[-1])
    return out + b


def rg_lru(u, w_r, b_r, w_i, b_i, lam):
    B, T, C = u.shape
    ub = u.reshape(B, T, RNN_BLOCKS, RNN_BLOCK_W)
    r = jax.nn.sigmoid(jnp.einsum('btnc,ncd->btnd', ub, w_r).reshape(B, T, C) + b_r)
    i = jax.nn.sigmoid(jnp.einsum('btnc,ncd->btnd', ub, w_i).reshape(B, T, C) + b_i)
    log_a = -LRU_C * r.astype(jnp.float32) * jax.nn.softplus(-lam.astype(jnp.float32))
    a = jnp.exp(log_a)
    mult = jnp.sqrt(-jnp.expm1(2.0 * log_a))
    mult = jnp.where((jnp.arange(T) == 0)[None, :, None], 1.0, mult)
    bx = mult * (i * u).astype(jnp.float32)

    def combine(left, right):
        a_l, b_l = left
        a_r, b_r2 = right
        return a_r * a_l, a_r * b_l + b_r2

    _, h = lax.associative_scan(combine, (a, bx), axis=1)
    return h.astype(u.dtype)


def recurrent_mixer(h, mem, w_in, conv_w, conv_b, w_r, b_r, w_i, b_i, lam, w_out, w_mem_kv):
    z = h @ w_in
    gate = jax.nn.gelu(z[..., :D_RNN])
    rec = causal_depthwise_conv(z[..., D_RNN:2 * D_RNN], conv_w, conv_b)
    rnn_out = rg_lru(rec, w_r, b_r, w_i, b_i, lam) * gate
    mem_out = memory_attention(z[..., 2 * D_RNN:], mem, w_mem_kv)
    return jnp.concatenate([rnn_out, mem_out], axis=-1) @ w_out


def differential_attention(q, k, v, lam_vecs, subln_g, lam_init):
    B, T = q.shape[0], q.shape[1]
    lv = lam_vecs.astype(jnp.float32)
    lam = jnp.exp(jnp.sum(lv[0] * lv[1])) - jnp.exp(jnp.sum(lv[2] * lv[3])) + lam_init
    slopes = jnp.exp2(-8.0 * (jnp.arange(DIFF_HEADS, dtype=jnp.float32) + 1.0) / DIFF_HEADS)
    pos = jnp.arange(T, dtype=jnp.float32)
    scale = DIFF_HEAD_DIM ** -0.5
    outs = []
    for start in range(0, T, Q_BLOCK):
        end = start + Q_BLOCK
        s = jnp.einsum('bqhcd,bkhcd->bhcqk', q[:, start:end], k[:, :end]).astype(jnp.float32) * scale
        dist = pos[start:end, None] - pos[None, :end]
        s = s - slopes[None, :, None, None, None] * dist
        s = jnp.where(dist >= 0, s, -jnp.inf)
        p = jax.nn.softmax(s, axis=-1)
        wgt = (p[:, :, 0] - lam * p[:, :, 1]).astype(v.dtype)
        outs.append(jnp.einsum('bhqk,bkhe->bqhe', wgt, v[:, :end]))
    o = jnp.concatenate(outs, axis=1)
    o = rms_norm(o, subln_g) * (1.0 - lam_init)
    return o.reshape(B, T, DIFF_V_W)


def diff_mixer(h, mem, k_sh, v_sh, w_q, lam_vecs, subln_g, w_out, w_mem_kv, lam_init):
    B, T, _ = h.shape
    q = h @ w_q
    q_diff = q[..., :DIFF_QK_W].reshape(B, T, DIFF_HEADS, 2, DIFF_HEAD_DIM)
    attn = differential_attention(q_diff, k_sh, v_sh, lam_vecs, subln_g, lam_init)
    mem_out = memory_attention(q[..., DIFF_QK_W:], mem, w_mem_kv)
    return jnp.concatenate([attn, mem_out], axis=-1) @ w_out


def swiglu(h, w13, w2):
    gu = h @ w13
    f = w2.shape[0]
    return (jax.nn.silu(gu[..., :f]) * gu[..., f:]) @ w2


def moe_swiglu(h, w_router, w13, w2):
    B, T, D = h.shape
    xt = h.reshape(-1, D)
    n_tok = xt.shape[0]
    logits = (xt @ w_router).astype(jnp.float32)
    top_v, top_e = lax.top_k(logits, TOP_K)
    gates = jax.nn.softmax(top_v, axis=-1)
    flat_e = top_e.reshape(-1)
    order = jnp.argsort(flat_e)
    sorted_e = flat_e[order]
    sorted_tok = order // TOP_K
    sorted_gate = gates.reshape(-1)[order].astype(xt.dtype)
    counts = jnp.bincount(flat_e, length=N_EXPERTS)
    padded = (counts + MOE_BLOCK - 1) // MOE_BLOCK * MOE_BLOCK
    start = jnp.cumsum(counts) - counts
    pstart = jnp.cumsum(padded) - padded
    dest = pstart[sorted_e] + jnp.arange(n_tok * TOP_K) - start[sorted_e]
    n_rows = n_tok * TOP_K + N_EXPERTS * MOE_BLOCK
    n_blocks = n_rows // MOE_BLOCK
    buf = jnp.zeros((n_rows, D), xt.dtype).at[dest].set(xt[sorted_tok])
    block_e = jnp.searchsorted(jnp.cumsum(padded), jnp.arange(n_blocks) * MOE_BLOCK, side='right')
    block_e = jnp.minimum(block_e, N_EXPERTS - 1)

    def expert_block(args):
        xb, e = args
        gu = xb @ w13[e]
        return (jax.nn.silu(gu[:, :EXPERT_DIM]) * gu[:, EXPERT_DIM:]) @ w2[e]

    yb = lax.map(expert_block, (buf.reshape(n_blocks, MOE_BLOCK, D), block_e))
    y_sorted = yb.reshape(n_rows, D)[dest] * sorted_gate[:, None]
    y = jax.ops.segment_sum(y_sorted, sorted_tok, num_segments=n_tok)
    return y.reshape(B, T, D)


def setup_inputs(seed: int = 0) -> dict:
    key = jax.random.key(seed)
    ks = jax.random.split(key, 32)
    D = D_MODEL

    def nrm(k, shape, scale):
        return jax.random.normal(k, shape, jnp.float32) * scale

    a_pow_c = jax.random.uniform(ks[9], (N_A_LAYERS, D_RNN), jnp.float32, 0.9, 0.999)
    a_base = a_pow_c ** (1.0 / LRU_C)
    a_lambda = jnp.log(a_base) - jnp.log1p(-a_base)
    return {
        "x": nrm(ks[0], (BATCH, SEQ, D), 1.0),
        "mem": nrm(ks[1], (BATCH, MEM_TOKENS, D), 1.0),
        "a_w_in": nrm(ks[2], (N_A_LAYERS, D, 2 * D_RNN + MEM_W), D ** -0.5),
        "a_conv_w": nrm(ks[3], (N_A_LAYERS, CONV_W, D_RNN), CONV_W ** -0.5),
        "a_conv_b": nrm(ks[4], (N_A_LAYERS, D_RNN), 0.01),
        "a_w_rgate": nrm(ks[5], (N_A_LAYERS, RNN_BLOCKS, RNN_BLOCK_W, RNN_BLOCK_W), RNN_BLOCK_W ** -0.5),
        "a_b_rgate": nrm(ks[6], (N_A_LAYERS, D_RNN), 0.1),
        "a_w_igate": nrm(ks[7], (N_A_LAYERS, RNN_BLOCKS, RNN_BLOCK_W, RNN_BLOCK_W), RNN_BLOCK_W ** -0.5),
        "a_b_igate": nrm(ks[8], (N_A_LAYERS, D_RNN), 0.1),
        "a_lambda": a_lambda,
        "a_w_out": nrm(ks[10], (N_A_LAYERS, D_RNN + MEM_W, D), (D_RNN + MEM_W) ** -0.5 * DEEPNORM_BETA),
        "w_kv_shared": nrm(ks[11], (D, DIFF_QK_W + DIFF_V_W), D ** -0.5),
        "b_w_q": nrm(ks[12], (N_B_LAYERS, D, DIFF_QK_W + MEM_W), D ** -0.5),
        "b_lambda": nrm(ks[13], (N_B_LAYERS, 4, DIFF_HEAD_DIM), 0.1),
        "b_subln_g": 1.0 + nrm(ks[14], (N_B_LAYERS, DIFF_V_DIM), 0.02),
        "b_w_out": nrm(ks[15], (N_B_LAYERS, DIFF_V_W + MEM_W, D), (DIFF_V_W + MEM_W) ** -0.5 * DEEPNORM_BETA),
        "mem_w_kv": nrm(ks[16], (DEPTH, D, 2 * MEM_W), D ** -0.5),
        "ffn_w13": nrm(ks[17], (N_DENSE_FFN, D, 2 * FFN_DIM), D ** -0.5),
        "ffn_w2": nrm(ks[18], (N_DENSE_FFN, FFN_DIM, D), FFN_DIM ** -0.5 * DEEPNORM_BETA),
        "moe_router": nrm(ks[19], (N_MOE_FFN, D, N_EXPERTS), D ** -0.5),
        "moe_w13": nrm(ks[20], (N_MOE_FFN, N_EXPERTS, D, 2 * EXPERT_DIM), D ** -0.5),
        "moe_w2": nrm(ks[21], (N_MOE_FFN, N_EXPERTS, EXPERT_DIM, D), EXPERT_DIM ** -0.5 * DEEPNORM_BETA),
        "ln_g": 1.0 + nrm(ks[22], (DEPTH, 2, D), 0.02),
        "ln_b": nrm(ks[23], (DEPTH, 2, D), 0.01),
    }


def reference(x, mem, a_w_in, a_conv_w, a_conv_b, a_w_rgate, a_b_rgate, a_w_igate, a_b_igate,
              a_lambda, a_w_out, w_kv_shared, b_w_q, b_lambda, b_subln_g, b_w_out, mem_w_kv,
              ffn_w13, ffn_w2, moe_router, moe_w13, moe_w2, ln_g, ln_b):
    h = x
    B, T, _ = x.shape
    k_sh = None
    v_sh = None
    for layer in range(DEPTH):
        if layer < N_A_LAYERS:
            i = layer
            y = recurrent_mixer(h, mem, a_w_in[i], a_conv_w[i], a_conv_b[i], a_w_rgate[i], a_b_rgate[i],
                                a_w_igate[i], a_b_igate[i], a_lambda[i], a_w_out[i], mem_w_kv[layer])
        else:
            j = layer - N_A_LAYERS
            if j == 0:
                kv = h @ w_kv_shared
                k_sh = kv[..., :DIFF_QK_W].reshape(B, T, DIFF_HEADS, 2, DIFF_HEAD_DIM)
                v_sh = kv[..., DIFF_QK_W:].reshape(B, T, DIFF_HEADS, DIFF_V_DIM)
            lam_init = 0.8 - 0.6 * math.exp(-0.3 * layer)
            y = diff_mixer(h, mem, k_sh, v_sh, b_w_q[j], b_lambda[j], b_subln_g[j], b_w_out[j],
                           mem_w_kv[layer], lam_init)
        h = layer_norm(DEEPNORM_ALPHA * h + y, ln_g[layer, 0], ln_b[layer, 0])
        if layer % 2 == 0:
            y = swiglu(h, ffn_w13[layer // 2], ffn_w2[layer // 2])
        else:
            y = moe_swiglu(h, moe_router[layer // 2], moe_w13[layer // 2], moe_w2[layer // 2])
        h = layer_norm(DEEPNORM_ALPHA * h + y, ln_g[layer, 1], ln_b[layer, 1])
    return h
```

```cpp
#include <hip/hip_runtime.h>
#include <cstdio>
#include <cstdint>

#define LAS __attribute__((address_space(3)))
#define GAS __attribute__((address_space(1)))
typedef unsigned short bf16;
typedef short bf16x8 __attribute__((ext_vector_type(8)));
typedef short s16x4 __attribute__((ext_vector_type(4)));
typedef float f32x2 __attribute__((ext_vector_type(2)));
typedef float f32x4 __attribute__((ext_vector_type(4)));
typedef float f32x16 __attribute__((ext_vector_type(16)));
typedef unsigned u32x2 __attribute__((ext_vector_type(2)));
typedef unsigned u32x4 __attribute__((ext_vector_type(4)));

__device__ __forceinline__ unsigned cvt_pk_bf16(float lo, float hi) { unsigned r; asm volatile("v_cvt_pk_bf16_f32 %0, %1, %2" : "=v"(r) : "v"(lo), "v"(hi)); return r; }
__device__ __forceinline__ float bf2f(unsigned short b) { return __uint_as_float(((unsigned)b) << 16); }
__device__ __forceinline__ float bflo(unsigned w) { return __uint_as_float(w << 16); }
__device__ __forceinline__ float bfhi(unsigned w) { return __uint_as_float(w & 0xffff0000u); }
__device__ __forceinline__ float fast_exp2(float x) { return __builtin_amdgcn_exp2f(x); }
__device__ __forceinline__ float fast_rcp(float x) { return __builtin_amdgcn_rcpf(x); }
__device__ __forceinline__ float sigmoidf_(float x) { return fast_rcp(1.0f + fast_exp2(-1.4426950408889634f * x)); }

namespace pg8 {
#define PG8_LAS __attribute__((address_space(3)))
typedef unsigned short bf16_t;
constexpr int BM = 256, BK = 64, HALF = 128, HTB = HALF * BK * 2  , STAGE_BYTES = 8 * HTB, NXCD = 8, WGM = 8;

__host__ __device__ __forceinline__ int lds_byte(int r, int c) { const int st = (r >> 4) * 2 + (c >> 5), rr = r & 15, cc = c & 31, ob = rr * 64 + cc * 2; return st * 1024 + (ob ^ (((ob >> 9) & 1) << 5)); }
__host__ __device__ __forceinline__ void stage_rc(int b, int& R, int& C) { const int st = b / 1024, sb = b % 1024, swz = sb ^ (((sb >> 9) & 1) << 5); R = (st >> 1) * 16 + swz / 64; C = (st & 1) * 32 + (swz % 64) / 2; }
__host__ __device__ __forceinline__ int perm32(int rho) { const int n = rho >> 4, i = rho & 15; return 8 * (i >> 2) + 4 * n + (i & 3); }

struct Unit { int pm, pn, e; };
struct Gemm { const bf16_t* A; const bf16_t* Bt; int M, N, K; size_t estride; };

struct StaticOrder {
    int nM, nN, nwg, G, c;
    __host__ __device__ void init(int M, int N, int G_, int c_) { nM = M / BM; nN = N / BM; nwg = nM * nN; G = G_; c = c_; }
    __host__ __device__ bool next(int i, Unit& u) const {
        const long L = (long)i * G + c; if (L >= nwg) return false;
        int wgid = (int)L; { const int q = nwg / NXCD, r = nwg % NXCD, xcd = wgid % NXCD, off = wgid / NXCD; wgid = (xcd < r ? xcd * (q + 1) : r * (q + 1) + (xcd - r) * q) + off; }
        const int nig = WGM * nN, gid = wgid / nig, fm = gid * WGM, gsz = (nM - fm) < WGM ? (nM - fm) : WGM;
        u.pm = fm + ((wgid % nig) % gsz); u.pn = (wgid % nig) / gsz; u.e = 0; return true;
    }
    __device__ __forceinline__ void a_ready(const Unit&) const {}
    __device__ __forceinline__ void done(const Unit&) const {}
};
struct GroupedOrder : StaticOrder {
    const int* tile_e;
    __device__ bool next(int i, Unit& u) const { if (!StaticOrder::next(i, u)) return false; u.e = __builtin_amdgcn_readfirstlane(tile_e[u.pm]); return true; }
};

struct EpiF32 {
    static constexpr bool PERM = false, AFTER_DRAIN = false;
    float* C; int ldc;
    __device__ __forceinline__ void operator()(const f32x4 (&acc)[2][2][4][2], const Unit& u, int wr, int wc, int fr, int fq) const {
        const int row0 = u.pm * BM + wr * 64 + fr, col0 = u.pn * BM + wc * 32 + 4 * fq;
#pragma unroll
        for (int ai = 0; ai < 2; ++ai)
#pragma unroll
            for (int m = 0; m < 4; ++m) { float* rowp = C + (size_t)(row0 + ai * HALF + m * 16) * ldc + col0;
#pragma unroll
                for (int bj = 0; bj < 2; ++bj)
#pragma unroll
                    for (int n = 0; n < 2; ++n) *(f32x4*)(rowp + bj * HALF + n * 16) = acc[ai][bj][m][n]; }
    }
};
__device__ __forceinline__ float gelu_tanh(float x) { const float y = x * (1.0f + 0.044715f * x * x); return x * fast_rcp(1.0f + fast_exp2(-2.302208198f * y)); }
struct EpiSwiGLU {
    static constexpr bool PERM = true, AFTER_DRAIN = false;
    bf16_t* H; int ldh;
    __device__ __forceinline__ void operator()(const f32x4 (&acc)[2][2][4][2], const Unit& u, int wr, int wc, int fr, int fq) const {
        const int row0 = u.pm * BM + wr * 64 + fr, col0 = u.pn * HALF + wc * 32 + 8 * fq;
#pragma unroll
        for (int ai = 0; ai < 2; ++ai)
#pragma unroll
            for (int m = 0; m < 4; ++m) { bf16_t* rowp = H + (size_t)(row0 + ai * HALF + m * 16) * ldh + col0;
                f32x4 h0, h1;
#pragma unroll
                for (int j = 0; j < 4; ++j) { const float g0 = acc[ai][0][m][0][j], g1 = acc[ai][0][m][1][j];
                    h0[j] = g0 * fast_rcp(1.0f + fast_exp2(-1.4426950408889634f * g0)) * acc[ai][1][m][0][j];
                    h1[j] = g1 * fast_rcp(1.0f + fast_exp2(-1.4426950408889634f * g1)) * acc[ai][1][m][1][j]; }
                u32x4 w; w.x = cvt_pk_bf16(h0[0], h0[1]); w.y = cvt_pk_bf16(h0[2], h0[3]); w.z = cvt_pk_bf16(h1[0], h1[1]); w.w = cvt_pk_bf16(h1[2], h1[3]);
                *(u32x4*)rowp = w; }
    }
};
struct EpiRowScale {
    static constexpr bool PERM = true, AFTER_DRAIN = false;
    bf16_t* O; int ldc; const float* rs;
    __device__ __forceinline__ void operator()(const f32x4 (&acc)[2][2][4][2], const Unit& u, int wr, int wc, int fr, int fq) const {
        const int row0 = u.pm * BM + wr * 64 + fr, col0 = u.pn * BM + wc * 32 + 8 * fq;
#pragma unroll
        for (int ai = 0; ai < 2; ++ai)
#pragma unroll
            for (int m = 0; m < 4; ++m) { const int row = row0 + ai * HALF + m * 16; const float g = rs[row]; bf16_t* rowp = O + (size_t)row * ldc + col0;
#pragma unroll
                for (int bj = 0; bj < 2; ++bj) { const f32x4 v0 = acc[ai][bj][m][0] * g, v1 = acc[ai][bj][m][1] * g;
                    u32x4 w; w.x = cvt_pk_bf16(v0[0], v0[1]); w.y = cvt_pk_bf16(v0[2], v0[3]); w.z = cvt_pk_bf16(v1[0], v1[1]); w.w = cvt_pk_bf16(v1[2], v1[3]);
                    *(u32x4*)(rowp + bj * HALF) = w; } }
    }
};

template <class Epi, class Sched, bool ALIGN_EPI = false, bool SP2 = false>
__device__ __forceinline__ void gemm_phase(PG8_LAS unsigned char* lds, const Gemm g, const Sched& S, const Epi& E) {
    const int tid = threadIdx.x, wid = __builtin_amdgcn_readfirstlane(tid >> 6), lane = tid & 63, wr = wid >> 2, wc = wid & 3, fr = lane & 15, fq = lane >> 4;
    const int K = g.K, nt = K / BK;
    unsigned voffA[2], voffB[2];
#pragma unroll
    for (int i = 0; i < 2; ++i) { int R, C; stage_rc(tid * 16 + i * 8192, R, C); const int Rb = Epi::PERM ? ((R & ~31) + perm32(R & 31)) : R;
        voffA[i] = (unsigned)(R * K + C) * 2u; voffB[i] = (unsigned)(Rb * K + C) * 2u; }
    const size_t kstep = (size_t)(BK * 2);
    const size_t hstep = (size_t)HALF * K * 2;
    const size_t tstep = 2 * hstep;
    const unsigned ldsw = (unsigned)wid * 1024u;
    const int aoff = lds_byte(wr * 64 + fr, fq * 8), boff = lds_byte(wc * 32 + fr, fq * 8);
#define PG8_SA(b, h) (((b) * 2 + (h)) * HTB)
#define PG8_SB(b, h) ((4 + (b) * 2 + (h)) * HTB)
#define PG8_STAGE(bufoff, gbase, voff) do { _Pragma("unroll") for (int _i = 0; _i < 2; ++_i) \
        __builtin_amdgcn_global_load_lds((const unsigned*)((const char*)(gbase) + (voff)[_i]), (PG8_LAS unsigned*)(lds + (bufoff) + ldsw + _i * 8192), 16, 0, 0); } while (0)
#define PG8_LDA(dst, b, h) do { _Pragma("unroll") for (int m = 0; m < 4; ++m) _Pragma("unroll") for (int k = 0; k < 2; ++k) dst[m][k] = *(const PG8_LAS bf16x8*)(lds + PG8_SA(b, h) + aoff + m * 2048 + k * 1024); } while (0)
#define PG8_LDB(dst, b, h) do { _Pragma("unroll") for (int n = 0; n < 2; ++n) _Pragma("unroll") for (int k = 0; k < 2; ++k) dst[n][k] = *(const PG8_LAS bf16x8*)(lds + PG8_SB(b, h) + boff + n * 2048 + k * 1024); } while (0)
#define PG8_MMA(ai, bj, At, Bt) do { __builtin_amdgcn_s_setprio(1); _Pragma("unroll") for (int m = 0; m < 4; ++m) _Pragma("unroll") for (int n = 0; n < 2; ++n) _Pragma("unroll") for (int k = 0; k < 2; ++k) \
        acc[ai][bj][m][n] = __builtin_amdgcn_mfma_f32_16x16x32_bf16(Bt[n][k], At[m][k], acc[ai][bj][m][n], 0, 0, 0); __builtin_amdgcn_s_setprio(0); } while (0)
#define PG8_WAIT_V(n) asm volatile("s_waitcnt vmcnt(" #n ")" ::: "memory")
#define PG8_WAIT_L(n) asm volatile("s_waitcnt lgkmcnt(" #n ")" ::: "memory")
#define PG8_BAR __builtin_amdgcn_s_barrier()
#define PG8_SCHED __builtin_amdgcn_sched_barrier(0)
    Unit cur, nxt; int ui = 0;
    if (!S.next(0, cur)) return;
    f32x4 acc[2][2][4][2];
#pragma unroll
    for (int a = 0; a < 2; ++a)
#pragma unroll
        for (int b = 0; b < 2; ++b)
#pragma unroll
            for (int m = 0; m < 4; ++m)
#pragma unroll
                for (int n = 0; n < 2; ++n) acc[a][b][m][n] = (f32x4){0.f, 0.f, 0.f, 0.f};
    bf16x8 At[4][2], B0[2][2], B1[2][2];
    const char* cA = (const char*)g.A + (size_t)cur.pm * tstep; const char* cB = (const char*)g.Bt + ((size_t)cur.e * g.estride + (size_t)cur.pn * tstep);
    S.a_ready(cur);
    if constexpr (SP2) {
        PG8_STAGE(PG8_SB(0, 0), cB, voffB); PG8_STAGE(PG8_SB(0, 1), cB + hstep, voffB); PG8_STAGE(PG8_SA(0, 0), cA, voffA); PG8_STAGE(PG8_SA(0, 1), cA + hstep, voffA);
        if (wr == 1) PG8_BAR;
        PG8_WAIT_V(2); PG8_BAR;
        PG8_STAGE(PG8_SB(1, 0), cB + kstep, voffB); PG8_STAGE(PG8_SA(1, 0), cA + kstep, voffA); PG8_STAGE(PG8_SB(1, 1), cB + hstep + kstep, voffB);
        PG8_WAIT_V(6); PG8_BAR;
    } else {
        PG8_STAGE(PG8_SB(0, 0), cB, voffB); PG8_STAGE(PG8_SA(0, 0), cA, voffA); PG8_STAGE(PG8_SB(0, 1), cB + hstep, voffB); PG8_STAGE(PG8_SA(0, 1), cA + hstep, voffA);
        if (wr == 1) PG8_BAR;
        PG8_WAIT_V(4); PG8_BAR;
        PG8_STAGE(PG8_SB(1, 0), cB + kstep, voffB); PG8_STAGE(PG8_SA(1, 0), cA + kstep, voffA); PG8_STAGE(PG8_SB(1, 1), cB + hstep + kstep, voffB);
        PG8_WAIT_V(6); PG8_BAR;
    }
    for (;;) {
        const bool has_next = S.next(ui + 1, nxt);
        const char* nA = has_next ? (const char*)g.A + (size_t)nxt.pm * tstep : cA; const char* nB = has_next ? (const char*)g.Bt + ((size_t)nxt.e * g.estride + (size_t)nxt.pn * tstep) : cB;
        for (int t = 0; t < nt; t += 2) {
            const bool last = (t == nt - 2);
            const char* a1 = cA + (size_t)(t + 1) * kstep;
            const char* a2 = last ? nA : cA + (size_t)(t + 2) * kstep; const char* b2 = last ? nB : cB + (size_t)(t + 2) * kstep;
            const char* a3 = a2 + kstep; const char* b3 = b2 + kstep;
            if (last && has_next) S.a_ready(nxt);
            if constexpr (SP2) {
            PG8_LDB(B0, 0, 0); PG8_LDB(B1, 0, 1); PG8_SCHED; PG8_LDA(At, 0, 0); PG8_STAGE(PG8_SA(1, 1), a1 + hstep, voffA);
            PG8_WAIT_V(8); PG8_WAIT_L(0); PG8_BAR; PG8_MMA(0, 0, At, B0); PG8_MMA(0, 1, At, B1); PG8_BAR; PG8_SCHED;
            PG8_LDA(At, 0, 1); PG8_STAGE(PG8_SB(0, 0), b2, voffB); PG8_STAGE(PG8_SB(0, 1), b2 + hstep, voffB); PG8_STAGE(PG8_SA(0, 0), a2, voffA);
            PG8_WAIT_V(8); PG8_WAIT_L(0); PG8_BAR; PG8_MMA(1, 0, At, B0); PG8_MMA(1, 1, At, B1); PG8_BAR; PG8_SCHED;
            PG8_LDB(B0, 1, 0); PG8_LDB(B1, 1, 1); PG8_SCHED; PG8_LDA(At, 1, 0); PG8_STAGE(PG8_SA(0, 1), a2 + hstep, voffA);
            PG8_WAIT_V(8); PG8_WAIT_L(0); PG8_BAR; PG8_MMA(0, 0, At, B0); PG8_MMA(0, 1, At, B1); PG8_BAR; PG8_SCHED;
            PG8_LDA(At, 1, 1); PG8_STAGE(PG8_SB(1, 0), b3, voffB); PG8_STAGE(PG8_SB(1, 1), b3 + hstep, voffB); PG8_STAGE(PG8_SA(1, 0), a3, voffA);
            PG8_WAIT_V(8); PG8_WAIT_L(0); PG8_BAR; PG8_MMA(1, 0, At, B0); PG8_MMA(1, 1, At, B1); PG8_BAR; PG8_SCHED;
            } else {
            PG8_LDB(B0, 0, 0); PG8_SCHED; PG8_LDA(At, 0, 0); PG8_STAGE(PG8_SA(1, 1), a1 + hstep, voffA);
            PG8_WAIT_L(8); PG8_BAR; PG8_WAIT_L(0); PG8_MMA(0, 0, At, B0); PG8_BAR; PG8_SCHED;
            PG8_LDB(B1, 0, 1); PG8_STAGE(PG8_SB(0, 0), b2, voffB);
            PG8_BAR; PG8_WAIT_L(0); PG8_MMA(0, 1, At, B1); PG8_BAR;
            PG8_LDA(At, 0, 1); PG8_STAGE(PG8_SA(0, 0), a2, voffA);
            PG8_BAR; PG8_WAIT_L(0); PG8_MMA(1, 0, At, B0); PG8_BAR; PG8_SCHED;
            PG8_STAGE(PG8_SB(0, 1), b2 + hstep, voffB);
            PG8_WAIT_V(6); PG8_BAR; PG8_MMA(1, 1, At, B1); PG8_BAR;
            PG8_LDB(B0, 1, 0); PG8_SCHED; PG8_LDA(At, 1, 0); PG8_STAGE(PG8_SA(0, 1), a2 + hstep, voffA);
            PG8_WAIT_L(8); PG8_BAR; PG8_WAIT_L(0); PG8_MMA(0, 0, At, B0); PG8_BAR; PG8_SCHED;
            PG8_LDB(B1, 1, 1); PG8_STAGE(PG8_SB(1, 0), b3, voffB);
            PG8_BAR; PG8_WAIT_L(0); PG8_MMA(0, 1, At, B1); PG8_BAR;
            PG8_LDA(At, 1, 1); PG8_STAGE(PG8_SA(1, 0), a3, voffA);
            PG8_BAR; PG8_WAIT_L(0); PG8_MMA(1, 0, At, B0); PG8_BAR; PG8_SCHED;
            PG8_STAGE(PG8_SB(1, 1), b3 + hstep, voffB);
            PG8_WAIT_V(6); PG8_BAR; PG8_MMA(1, 1, At, B1); PG8_BAR;
            }
        }
        if constexpr (ALIGN_EPI) { if (wr == 0) PG8_BAR; }
        if constexpr (!Epi::AFTER_DRAIN) { E(acc, cur, wr, wc, fr, fq); S.done(cur); }
        if (!has_next) break;
#pragma unroll
        for (int a = 0; a < 2; ++a)
#pragma unroll
            for (int b = 0; b < 2; ++b)
#pragma unroll
                for (int m = 0; m < 4; ++m)
#pragma unroll
                    for (int n = 0; n < 2; ++n) acc[a][b][m][n] = (f32x4){0.f, 0.f, 0.f, 0.f};
        cur = nxt; cA = nA; cB = nB; ++ui;
        if constexpr (ALIGN_EPI) { if (wr == 1) PG8_BAR; }
    }
    PG8_WAIT_V(0);
    if constexpr (!ALIGN_EPI) { if (wr == 0) PG8_BAR; }
    PG8_BAR;
    if constexpr (Epi::AFTER_DRAIN) { E.fused(acc, cur, wr, wc, fr, fq, lds, wid, lane); S.done(cur); }
#undef PG8_SA
#undef PG8_SB
#undef PG8_STAGE
#undef PG8_LDA
#undef PG8_LDB
#undef PG8_MMA
#undef PG8_WAIT_V
#undef PG8_WAIT_L
#undef PG8_BAR
#undef PG8_SCHED
}
}

namespace att {
typedef short v4i16_t __attribute__((ext_vector_type(4)));
constexpr int LDS_K = 0, LDS_V = 16384, LDS_WS = 32768, LDS_OST = 36864, LDS_BYTES = LDS_OST + 8 * 8192;
__device__ __forceinline__ int crow(int r, int hi) { return (r & 3) + 8 * (r >> 2) + 4 * hi; }
__device__ __forceinline__ s16x4 vtr(const LAS unsigned char* p) { return __builtin_bit_cast(s16x4, __builtin_amdgcn_ds_read_tr16_b64_v4i16((LAS v4i16_t*)p)); }
__device__ __forceinline__ float xhalf_max(float m) { auto rr = __builtin_amdgcn_permlane32_swap(__float_as_uint(m), __float_as_uint(m), false, false); return fmaxf(__uint_as_float(rr[0]), __uint_as_float(rr[1])); }
__device__ __forceinline__ float xhalf_sum(float m) { auto rr = __builtin_amdgcn_permlane32_swap(__float_as_uint(m), __float_as_uint(m), false, false); return __uint_as_float(rr[0]) + __uint_as_float(rr[1]); }

template <int DQK, int DV, bool CAUSAL>
__device__ __forceinline__ void attn_core(const bf16* Qw, int ldq, const bf16* Kh, int ldk, const bf16* Vh, int ldv, int NT, int qpos0, int qref, float slope2,
                                          LAS unsigned char* shm, f32x16 (&o)[DV / 32]) {
    const int tid = threadIdx.x, lane = tid & 63, r32 = lane & 31, hi = lane >> 5; const int wid = __builtin_amdgcn_readfirstlane(tid >> 6);
    LAS float* wsf = (LAS float*)(shm + LDS_WS) + wid * 64;
    constexpr int NKC = DQK / 64, NVP = DV / 64, ND = DQK / 16, NO = DV / 32;
    bf16x8 qr[ND];
#pragma unroll
    for (int d0 = 0; d0 < ND; ++d0) qr[d0] = *(const bf16x8*)(Qw + (size_t)r32 * ldq + d0 * 16 + hi * 8);
    u32x4 kreg[NKC], vreg[NVP];
#pragma unroll
    for (int i = 0; i < NKC; ++i) kreg[i] = *(const u32x4*)(Kh + (size_t)lane * ldk + (wid + 8 * i) * 8);
#pragma unroll
    for (int i = 0; i < NVP; ++i) { const int pc = wid + 8 * i; vreg[i] = *(const u32x4*)(Vh + (size_t)(16 * (pc & 3) + (lane >> 2)) * ldv + (pc >> 2) * 32 + (lane & 3) * 8); }
    float m = -1e30f, l = 0.f;
#pragma unroll
    for (int d = 0; d < NO; ++d) o[d] = f32x16{};
    const LAS unsigned char* kb = shm + LDS_K + hi * 1024 + r32 * 16;
    const LAS unsigned char* vp = shm + LDS_V + ((lane >> 4) & 1) * 32 + (lane & 3) * 8 + (4 * hi + ((lane & 15) >> 2)) * 64;
    for (int t = 0; t < NT; ++t) {
        __syncthreads();
#pragma unroll
        for (int i = 0; i < NKC; ++i) *(LAS u32x4*)(shm + LDS_K + (wid + 8 * i) * 1024 + lane * 16) = kreg[i];
#pragma unroll
        for (int i = 0; i < NVP; ++i) *(LAS u32x4*)(shm + LDS_V + (wid + 8 * i) * 1024 + lane * 16) = vreg[i];
        if (t + 1 < NT) {
#pragma unroll
            for (int i = 0; i < NKC; ++i) kreg[i] = *(const u32x4*)(Kh + (size_t)(64 * (t + 1) + lane) * ldk + (wid + 8 * i) * 8);
#pragma unroll
            for (int i = 0; i < NVP; ++i) { const int pc = wid + 8 * i; vreg[i] = *(const u32x4*)(Vh + (size_t)(64 * (t + 1) + 16 * (pc & 3) + (lane >> 2)) * ldv + (pc >> 2) * 32 + (lane & 3) * 8); }
        }
        __syncthreads();
        const bool active = !CAUSAL || (64 * t <= qpos0 + 31);
        if (active) {
            f32x16 p0, p1;
#pragma unroll
            for (int r = 0; r < 16; ++r) { const float bz = slope2 * (float)(64 * t + crow(r, hi) - qref); p0[r] = bz; p1[r] = bz + 32.0f * slope2; }
#pragma unroll
            for (int d0 = 0; d0 < ND; ++d0) {
                const bf16x8 b0 = *(const LAS bf16x8*)(kb + d0 * 2048), b1 = *(const LAS bf16x8*)(kb + d0 * 2048 + 512);
                p0 = __builtin_amdgcn_mfma_f32_32x32x16_bf16(b0, qr[d0], p0, 0, 0, 0);
                p1 = __builtin_amdgcn_mfma_f32_32x32x16_bf16(b1, qr[d0], p1, 0, 0, 0);
            }
            if (CAUSAL && (64 * t + 63 > qpos0)) {
                const int q = qpos0 + r32;
#pragma unroll
                for (int r = 0; r < 16; ++r) { const int kv = 64 * t + crow(r, hi); if (kv > q) p0[r] = -INFINITY; if (kv + 32 > q) p1[r] = -INFINITY; }
            }
            float rm = fmaxf(p0[0], p1[0]);
#pragma unroll
            for (int r = 1; r < 16; ++r) rm = fmaxf(rm, fmaxf(p0[r], p1[r]));
            rm = xhalf_max(rm);
            const float mn = fmaxf(m, rm), alpha = fast_exp2(m - mn); m = mn;
            float s = 0.f;
#pragma unroll
            for (int r = 0; r < 16; ++r) { p0[r] = fast_exp2(p0[r] - mn); p1[r] = fast_exp2(p1[r] - mn); s += p0[r] + p1[r]; }
            l = l * alpha + s;
            if (hi == 0) wsf[r32] = alpha;
#pragma unroll
            for (int r = 0; r < 16; ++r) { const float f = wsf[crow(r, hi)];
#pragma unroll
                for (int d = 0; d < NO; ++d) o[d][r] *= f; }
            bf16x8 pa[4];
#pragma unroll
            for (int ks = 0; ks < 4; ++ks) { u32x4 w;
#pragma unroll
                for (int j = 0; j < 4; ++j) { const int b = 8 * (ks & 1) + 2 * j; w[j] = (ks < 2) ? cvt_pk_bf16(p0[b], p0[b + 1]) : cvt_pk_bf16(p1[b], p1[b + 1]); }
                pa[ks] = __builtin_bit_cast(bf16x8, w); }
#pragma unroll
            for (int d0 = 0; d0 < NO; ++d0) {
#pragma unroll
                for (int ks = 0; ks < 4; ++ks) {
                    const s16x4 lo = vtr(vp + d0 * 4096 + ks * 1024), hh = vtr(vp + d0 * 4096 + ks * 1024 + 512);
                    const bf16x8 vf = (bf16x8){lo[0], lo[1], lo[2], lo[3], hh[0], hh[1], hh[2], hh[3]};
                    o[d0] = __builtin_amdgcn_mfma_f32_32x32x16_bf16(pa[ks], vf, o[d0], 0, 0, 0);
                }
                __builtin_amdgcn_sched_barrier(0);
            }
        }
    }
    l = xhalf_sum(l);
    if (hi == 0) wsf[32 + r32] = fast_rcp(l);
#pragma unroll
    for (int r = 0; r < 16; ++r) { const float f = wsf[32 + crow(r, hi)];
#pragma unroll
        for (int d = 0; d < NO; ++d) o[d][r] *= f; }
}
__device__ __forceinline__ void store_o128(const f32x16 (&o)[4], bf16* Ow, int ldo, LAS unsigned char* shm) {
    const int tid = threadIdx.x, lane = tid & 63, r32 = lane & 31, hi = lane >> 5; const int wid = __builtin_amdgcn_readfirstlane(tid >> 6);
    LAS bf16* stg = (LAS bf16*)(shm + LDS_OST + wid * 8192);
#pragma unroll
    for (int r = 0; r < 16; ++r) { const int orow = crow(r, hi);
#pragma unroll
        for (int d0 = 0; d0 < 4; ++d0) stg[orow * 128 + d0 * 32 + r32] = (bf16)(cvt_pk_bf16(o[d0][r], 0.f) & 0xffffu); }
#pragma unroll
    for (int i = 0; i < 8; ++i) { const int row = i * 4 + (lane >> 4), ch = lane & 15; const u32x4 v = *(const LAS u32x4*)(stg + row * 128 + ch * 8); *(u32x4*)(Ow + (size_t)row * ldo + ch * 8) = v; }
}
}

constexpr int NWAVES = 8;
constexpr int BATCH = 8, T = 4096, D = 1024, M = BATCH * T;
constexpr int DZ = 2560, DCAT = 1536, FF = 3584, NKVQ = 3584, NEXP = 8, MEMT = 256, MEMROWS = BATCH * MEMT;
constexpr int MOE_ROWS = 2 * M + NEXP * 256;
constexpr int NSLOT = M / 16;
constexpr float LN_EPS = 1e-5f, DN_ALPHA = 1.41421356237f;
constexpr float LOG2E = 1.4426950408889634f;
constexpr float C2Q = 0.125f * LOG2E;
constexpr float C2M = 0.08838834764831845f * LOG2E;
constexpr float LAM_INIT = 0.35550906759f;

constexpr size_t MiB = 1u << 20;
constexpr size_t WS_CTL = 0, CTL_ZERO_BYTES = 64 * 1024;
constexpr size_t WS_WZ = 1 * MiB, WS_WO0 = 6 * MiB, WS_W13 = 9 * MiB, WS_W2 = 23 * MiB, WS_WMKV = 30 * MiB, WS_WKVQ = 34 * MiB, WS_WO1 = 41 * MiB, WS_WG = 44 * MiB,
                 WS_WM13 = 45 * MiB, WS_WM2 = 157 * MiB;
constexpr size_t WS_ROUTE = 213 * MiB;
constexpr size_t RT_E = WS_ROUTE, RT_G = RT_E + (size_t)M * 4, RT_WCNT = RT_G + (size_t)M * 8, RT_STOK = RT_WCNT + NSLOT * 8 * 4, RT_SGATE = RT_STOK + (size_t)MOE_ROWS * 4,
                 RT_TDEST = RT_SGATE + (size_t)MOE_ROWS * 4, RT_TILEE = RT_TDEST + (size_t)M * 8, RT_META = RT_TILEE + 2048, RT_END = RT_META + 256;
static_assert(RT_END <= 215 * MiB, "route region");
constexpr size_t WS_AGG = 215 * MiB, WS_MKV = 216 * MiB, WS_MEMB = 224 * MiB;
constexpr size_t WS_H3 = 228 * MiB, WS_STASH = 228 * MiB;
constexpr size_t WS_BIG = 292 * MiB;
constexpr size_t WS_XB = WS_BIG, WS_ZG = WS_BIG + 64 * MiB, WS_U = WS_BIG + 128 * MiB, WS_QM0 = WS_BIG + 192 * MiB;
constexpr size_t WS_CAT = WS_BIG + 224 * MiB, WS_Y = WS_BIG + 320 * MiB, WS_H1 = WS_BIG + 448 * MiB, WS_H2 = WS_BIG + 512 * MiB;
constexpr size_t WS_HID = WS_BIG, WS_K = WS_BIG, WS_V = WS_BIG + 64 * MiB, WS_QD = WS_BIG + 128 * MiB, WS_QM1 = WS_BIG + 192 * MiB;
constexpr size_t WS_HIDM = WS_BIG, WS_AG = WS_BIG + 462 * MiB, WS_Y2 = WS_AG, WS_END = WS_AG + 132 * MiB;
static_assert((size_t)MOE_ROWS * FF * 2 <= 462 * MiB && (size_t)MOE_ROWS * D * 2 <= 132 * MiB, "moe buffers");
constexpr int CW_TMO = 0, CW_CODE = 1, CW_BAR = 4096;

constexpr int RING_OFF = 0, RING_BYTES = 131072, XTRA_OFF = 131072, XTRA_BYTES = 24576, LDSCTL_OFF = XTRA_OFF + XTRA_BYTES, LDS_BYTES = LDSCTL_OFF + 512;

typedef GAS unsigned gu32;
#define RLX_AGENT __ATOMIC_RELAXED, __HIP_MEMORY_SCOPE_AGENT
#define LDS_WAIT() asm volatile("s_waitcnt lgkmcnt(0)" ::: "memory")
#define VM_WAIT() asm volatile("s_waitcnt vmcnt(0)" ::: "memory")
__device__ __forceinline__ unsigned f2bf(float f) { unsigned u = __builtin_bit_cast(unsigned, f); return (u + 0x7fffu + ((u >> 16) & 1u)) >> 16; }
__device__ __forceinline__ unsigned pk2(float lo, float hi) { return f2bf(lo) | (f2bf(hi) << 16); }
__device__ __forceinline__ float wave_sum(float v) {
#pragma unroll
    for (int o = 1; o < 64; o <<= 1) v += __shfl_xor(v, o);
    return v;
}

#define XB_TMO      128
#define XB_XCNT(j)  (256  + 64 * (j))
#define XB_XSUB(j)  (1280 + 64 * (j))
#define XB_XGEN(j)  (2304 + 64 * (j))
#define XB_TOP      3328
#define XB_TOPGEN   3392
#define XCD_BAR_WORDS 3456
#define XB_SPIN_CAP (1u << 18)

__device__ __forceinline__ unsigned xb_ld(unsigned* p)              { return __hip_atomic_load(p, __ATOMIC_RELAXED, __HIP_MEMORY_SCOPE_AGENT); }
__device__ __forceinline__ unsigned xb_add(unsigned* p, unsigned v) { return __hip_atomic_fetch_add(p, v, __ATOMIC_RELAXED, __HIP_MEMORY_SCOPE_AGENT); }
__device__ __forceinline__ unsigned xb_xcc_id() { return (unsigned)__builtin_amdgcn_s_getreg((3 << 11) | 20) & 0xFu; }
#define XB_SPIN(cond, bar) do { unsigned _sp = 0; while (cond) { __builtin_amdgcn_s_sleep(1); \
    if ((++_sp & 255u) == 0u) { if (xb_ld(&(bar)[XB_TMO])) break; if (_sp > XB_SPIN_CAP) { atomicAdd(&(bar)[XB_TMO], 1u); break; } } } } while (0)

struct XcdBarrier {
    unsigned* bar; unsigned x;
    volatile LAS unsigned* st;
};

__device__ __forceinline__ XcdBarrier xcd_barrier_post(unsigned* bar, volatile LAS unsigned* st) {
    XcdBarrier b; b.bar = bar; b.x = xb_xcc_id(); b.st = st;
    if (threadIdx.x == 0) (void)xb_add(&bar[XB_XCNT(b.x)], 1u);
    return b;
}
__device__ __forceinline__ void xcd_barrier_complete(unsigned* bar, unsigned x, unsigned& nloc, unsigned& nx) {
    const unsigned G = gridDim.x * gridDim.y * gridDim.z;
    unsigned sum, cnt, mine, sp = 0u;
    for (;;) {
        sum = 0u; cnt = 0u; mine = 0u;
#pragma unroll
        for (unsigned j = 0; j < 16; ++j) { const unsigned c = xb_ld(&bar[XB_XCNT(j)]); sum += c; cnt += (c > 0u) ? 1u : 0u; mine = (j == x) ? c : mine; }
        if (sum == G) break;
        __builtin_amdgcn_s_sleep(1);
        if ((++sp & 255u) == 0u) { if (xb_ld(&bar[XB_TMO])) break; if (sp > XB_SPIN_CAP) { atomicAdd(&bar[XB_TMO], 1u); break; } }
    }
    nloc = mine > 0u ? mine : 1u; nx = cnt > 0u ? cnt : 1u;
}

__device__ __forceinline__ void xcd_barrier(const XcdBarrier& b) {
    asm volatile("s_waitcnt vmcnt(0)" ::: "memory");
    __syncthreads();
    if (threadIdx.x == 0) {
        unsigned* bar = b.bar;
        __builtin_amdgcn_s_waitcnt(0);
        unsigned nloc = b.st[0], nx = b.st[1];
        if (nloc == 0u) { xcd_barrier_complete(bar, b.x, nloc, nx); b.st[0] = nloc; b.st[1] = nx; }
        const unsigned old = xb_add(&bar[XB_XSUB(b.x)], 1u);
        const unsigned gen = old / nloc;
        if (old + 1u == (gen + 1u) * nloc) {
            __builtin_amdgcn_fence(__ATOMIC_RELEASE, "agent");
            asm volatile("s_waitcnt vmcnt(0)" ::: "memory");
            const unsigned og = xb_add(&bar[XB_TOP], 1u);
            const unsigned tg = og / nx;
            if (og + 1u == (tg + 1u) * nx) xb_add(&bar[XB_TOPGEN], 1u);
            else XB_SPIN(xb_ld(&bar[XB_TOPGEN]) == tg, bar);
            __builtin_amdgcn_fence(__ATOMIC_ACQUIRE, "agent");
            xb_add(&bar[XB_XGEN(b.x)], 1u);
            asm volatile("s_waitcnt vmcnt(0)" ::: "memory");
        } else {
            XB_SPIN(xb_ld(&bar[XB_XGEN(b.x)]) == gen, bar);
            __builtin_amdgcn_fence(__ATOMIC_ACQUIRE, "agent");
            asm volatile("s_waitcnt vmcnt(0)" ::: "memory");
        }
    }
    __syncthreads();
}

enum { IN_X = 0, IN_MEM, IN_A_W_IN, IN_A_CONV_W, IN_A_CONV_B, IN_A_W_RG, IN_A_B_RG, IN_A_W_IG, IN_A_B_IG, IN_A_LAMBDA, IN_A_W_OUT, IN_W_KV, IN_B_W_Q, IN_B_LAMBDA, IN_B_SUBLN,
       IN_B_W_OUT, IN_MEM_W_KV, IN_FFN_W13, IN_FFN_W2, IN_MOE_ROUTER, IN_MOE_W13, IN_MOE_W2, IN_LN_G, IN_LN_B, N_IN };
struct Args { const float* in[N_IN]; float* out; unsigned char* ws; int ph_lo, ph_hi; };
constexpr int N_PHASES = 17;


namespace pg8 {
template <int MODE> struct EpiSegT {
    static constexpr bool PERM = true, AFTER_DRAIN = false;
    unsigned char* ws;
    __device__ __forceinline__ void operator()(const f32x4 (&acc)[2][2][4][2], const Unit& u, int wr, int wc, int fr, int fq) const {
        size_t off; int ldc, ts; float scl; bool act = false;
        if (MODE == 0) { if (u.pn < 4) { off = WS_ZG; ldc = D; ts = 0; scl = 1.f; act = true; } else if (u.pn < 8) { off = WS_U; ldc = D; ts = 4; scl = 1.f; } else { off = WS_QM0; ldc = 512; ts = 8; scl = C2M; } }
        else if (MODE == 1) { off = WS_MKV; ldc = 2 * D; ts = 0; scl = 1.f; }
        else { if (u.pn < 4) { off = WS_K; ldc = D; ts = 0; scl = 1.f; } else if (u.pn < 8) { off = WS_V; ldc = D; ts = 4; scl = 1.f; } else if (u.pn < 12) { off = WS_QD; ldc = D; ts = 8; scl = C2Q; } else { off = WS_QM1; ldc = 512; ts = 12; scl = C2M; } }
        bf16_t* base = (bf16_t*)(ws + off);
        const int row0 = u.pm * BM + wr * 64 + fr, col0 = (u.pn - ts) * BM + wc * 32 + 8 * fq;
#pragma unroll
        for (int ai = 0; ai < 2; ++ai)
#pragma unroll
            for (int m = 0; m < 4; ++m) { bf16_t* rowp = base + (size_t)(row0 + ai * HALF + m * 16) * ldc + col0;
#pragma unroll
                for (int bj = 0; bj < 2; ++bj) { f32x4 v0 = acc[ai][bj][m][0], v1 = acc[ai][bj][m][1];
                    if (act) {
#pragma unroll
                        for (int j = 0; j < 4; ++j) { v0[j] = gelu_tanh(v0[j]); v1[j] = gelu_tanh(v1[j]); } }
                    v0 = v0 * scl; v1 = v1 * scl;
                    u32x4 w; w.x = cvt_pk_bf16(v0[0], v0[1]); w.y = cvt_pk_bf16(v0[2], v0[3]); w.z = cvt_pk_bf16(v1[0], v1[1]); w.w = cvt_pk_bf16(v1[2], v1[3]);
                    *(u32x4*)(rowp + bj * HALF) = w; } }
    }
};
}

__device__ __forceinline__ void p0_transpose_item(const float* W, int K, int N, bf16* WT, int k0, int n0, int drow0, LAS float* scr, int lane) {
    float v[32];
#pragma unroll
    for (int i = 0; i < 32; ++i) { const int kk = 2 * i + (lane >> 5); v[i] = W[(size_t)(k0 + kk) * N + n0 + (lane & 31)]; }
#pragma unroll
    for (int i = 0; i < 32; ++i) { const int kk = 2 * i + (lane >> 5); scr[kk * 33 + (lane & 31)] = v[i]; }
    LDS_WAIT(); asm volatile("" ::: "memory");
    const int c = lane & 7;
#pragma unroll
    for (int j = 0; j < 4; ++j) { const int n = (lane >> 3) + 8 * j; const LAS float* s = scr + (8 * c) * 33 + n;
        u32x4 o; o.x = pk2(s[0 * 33], s[1 * 33]); o.y = pk2(s[2 * 33], s[3 * 33]); o.z = pk2(s[4 * 33], s[5 * 33]); o.w = pk2(s[6 * 33], s[7 * 33]);
        *(u32x4*)(WT + (size_t)(drow0 + n) * K + k0 + 8 * c) = o; }
    LDS_WAIT(); asm volatile("" ::: "memory");
}
__device__ __forceinline__ void p0_job(const float* W, int K, int N, bf16* WT, int mode, int row_off, int& base, int gw, int NGW, LAS float* scr, int lane) {
    const int nblk = N / 32, nitems = (K / 64) * nblk;
    int it0 = (gw - (base % NGW) + NGW) % NGW;
    for (int it = it0; it < nitems; it += NGW) {
        const int kb = it / nblk, nb = it % nblk, n0 = 32 * nb;
        int drow0;
        if (mode == 0) drow0 = row_off + n0;
        else { const int isu = n0 >= FF, nn = isu ? n0 - FF : n0; drow0 = 256 * (nn / 128) + 128 * isu + (nn % 128); }
        p0_transpose_item(W, K, N, WT, 64 * kb, n0, drow0, scr, lane);
    }
    base += nitems;
}
__device__ __forceinline__ void p0_cvt_rows(const float* X, bf16* XB, size_t n8, size_t gtid, size_t nthreads) {
    for (size_t i = gtid; i < n8; i += nthreads) { const f32x4 a = *(const f32x4*)(X + i * 8), b = *(const f32x4*)(X + i * 8 + 4);
        u32x4 o; o.x = pk2(a[0], a[1]); o.y = pk2(a[2], a[3]); o.z = pk2(b[0], b[1]); o.w = pk2(b[2], b[3]); *(u32x4*)(XB + i * 8) = o; }
}

template <int NR> __device__ __forceinline__ void wave_sum_n(float (&x)[NR]) {
#pragma unroll
    for (int o = 1; o < 64; o <<= 1) {
#pragma unroll
        for (int i = 0; i < NR; ++i) x[i] += __shfl_xor(x[i], o); }
}
template <int NR, bool HPF32, bool ADD2>
__device__ __forceinline__ void ln_rows(const float* Y, const void* HP, const bf16* Y2, const int* tdest, size_t m0, const float* g, const float* b, bf16* OB, float* OF, f32x4 (&v)[NR][4], int lane) {
#pragma unroll
    for (int i = 0; i < NR; ++i) {
        const size_t m = m0 + i;
        const bf16 *a0 = nullptr, *a1 = nullptr;
        if (ADD2) { const int d0 = __builtin_amdgcn_readfirstlane(tdest[2 * m]), d1 = __builtin_amdgcn_readfirstlane(tdest[2 * m + 1]); a0 = Y2 + (size_t)d0 * D; a1 = Y2 + (size_t)d1 * D; }
#pragma unroll
        for (int j = 0; j < 4; ++j) {
            f32x4 h;
            if (HPF32) h = *((const f32x4*)((const float*)HP + m * D) + lane + 64 * j);
            else { const u32x2 w = *((const u32x2*)((const bf16*)HP + m * D) + lane + 64 * j); h = (f32x4){bflo(w.x), bfhi(w.x), bflo(w.y), bfhi(w.y)}; }
            f32x4 y;
            if (ADD2) { const u32x2 w0 = *((const u32x2*)a0 + lane + 64 * j), w1 = *((const u32x2*)a1 + lane + 64 * j);
                y = (f32x4){bflo(w0.x) + bflo(w1.x), bfhi(w0.x) + bfhi(w1.x), bflo(w0.y) + bflo(w1.y), bfhi(w0.y) + bfhi(w1.y)}; }
            else y = *((const f32x4*)(Y + m * D) + lane + 64 * j);
            v[i][j] = h * DN_ALPHA + y;
        }
    }
    float s[NR];
#pragma unroll
    for (int i = 0; i < NR; ++i) { s[i] = 0.f;
#pragma unroll
        for (int j = 0; j < 4; ++j) s[i] += (v[i][j].x + v[i][j].y) + (v[i][j].z + v[i][j].w); }
    wave_sum_n<NR>(s);
    float s2[NR];
#pragma unroll
    for (int i = 0; i < NR; ++i) { const float mean = s[i] * (1.f / D); s2[i] = 0.f;
#pragma unroll
        for (int j = 0; j < 4; ++j) { v[i][j] = v[i][j] - mean; s2[i] += (v[i][j].x * v[i][j].x + v[i][j].y * v[i][j].y) + (v[i][j].z * v[i][j].z + v[i][j].w * v[i][j].w); } }
    wave_sum_n<NR>(s2);
#pragma unroll
    for (int j = 0; j < 4; ++j) { const f32x4 gg = *((const f32x4*)g + lane + 64 * j), bb = *((const f32x4*)b + lane + 64 * j);
#pragma unroll
        for (int i = 0; i < NR; ++i) { const size_t m = m0 + i; const float rstd = 1.f / sqrtf(s2[i] * (1.f / D) + LN_EPS);
            v[i][j] = v[i][j] * rstd * gg + bb;
            if (OB) { u32x2 w; w.x = pk2(v[i][j].x, v[i][j].y); w.y = pk2(v[i][j].z, v[i][j].w); *((u32x2*)(OB + m * D) + lane + 64 * j) = w; }
            if (OF) *((f32x4*)(OF + m * D) + lane + 64 * j) = v[i][j]; } }
}

constexpr float LOG2E_ = 1.4426950408889634f;
__device__ __forceinline__ int scan_row(int tl) { return 32 * (tl >> 5) + att::crow(tl & 15, (tl >> 4) & 1); }
__device__ __forceinline__ void scan_unit(int pass, int b, int n, int c, bool loadW, const bf16* U, const bf16* ZG, bf16* CAT, const bf16* Wg, f32x2* agg,
                                          const float* conv_w, const float* conv_b, const float* b_rg, const float* b_ig, const float* lam, LAS unsigned char* lds) {
    const int tid = threadIdx.x, lane = tid & 63, r32 = lane & 31, hi = lane >> 5; const int wv = __builtin_amdgcn_readfirstlane(tid >> 6);
    LAS unsigned char* At = lds; LAS unsigned char* Wt = lds + 65536;
    LAS f32x2* comp = (LAS f32x2*)(lds + XTRA_OFF);
    LAS float* cin = (LAS float*)(lds + XTRA_OFF + 8192);
    const int t0 = c * 256; const size_t rowbase = (size_t)b * T + t0;
    __syncthreads();
    if (loadW) {
        for (int i = tid; i < 4096; i += 512) { const int row = i >> 4, c16 = i & 15; const u32x4 v = *(const u32x4*)(Wg + ((size_t)n * 256 + row) * 128 + c16 * 8);
            *(LAS u32x4*)(Wt + row * 256 + ((c16 ^ (row & 15)) << 4)) = v; }
    }
    {
        const int ch8 = tid & 15, tg = tid >> 4, chb = n * 128 + ch8 * 8;
        float cw[4][8], cb[8];
#pragma unroll
        for (int j = 0; j < 4; ++j) { const f32x4 a = *(const f32x4*)(conv_w + j * D + chb), bq = *(const f32x4*)(conv_w + j * D + chb + 4);
            cw[j][0] = a[0]; cw[j][1] = a[1]; cw[j][2] = a[2]; cw[j][3] = a[3]; cw[j][4] = bq[0]; cw[j][5] = bq[1]; cw[j][6] = bq[2]; cw[j][7] = bq[3]; }
        { const f32x4 a = *(const f32x4*)(conv_b + chb), bq = *(const f32x4*)(conv_b + chb + 4); cb[0] = a[0]; cb[1] = a[1]; cb[2] = a[2]; cb[3] = a[3]; cb[4] = bq[0]; cb[5] = bq[1]; cb[6] = bq[2]; cb[7] = bq[3]; }
        u32x4 uw[11];
#pragma unroll
        for (int k = 0; k < 11; ++k) { const int tt = tg * 8 - 3 + k; uw[k] = (u32x4){0u, 0u, 0u, 0u};
            if (t0 + tt >= 0) uw[k] = *(const u32x4*)(U + (size_t)((long)rowbase + tt) * D + chb); }
#pragma unroll
        for (int k = 0; k < 8; ++k) { float rr[8];
#pragma unroll
            for (int e = 0; e < 8; ++e) rr[e] = cb[e];
#pragma unroll
            for (int j = 0; j < 4; ++j) { const u32x4 w = uw[k + j];
                rr[0] += cw[j][0] * bflo(w.x); rr[1] += cw[j][1] * bfhi(w.x); rr[2] += cw[j][2] * bflo(w.y); rr[3] += cw[j][3] * bfhi(w.y);
                rr[4] += cw[j][4] * bflo(w.z); rr[5] += cw[j][5] * bfhi(w.z); rr[6] += cw[j][6] * bflo(w.w); rr[7] += cw[j][7] * bfhi(w.w); }
            const int tl = tg * 8 + k, row = scan_row(tl);
            u32x4 w; w.x = pk2(rr[0], rr[1]); w.y = pk2(rr[2], rr[3]); w.z = pk2(rr[4], rr[5]); w.w = pk2(rr[6], rr[7]);
            *(LAS u32x4*)(At + row * 256 + ((ch8 ^ (row & 15)) << 4)) = w; }
    }
    if (pass == 2 && tid < 128) { float H = 0.f; for (int cc = 0; cc < c; ++cc) { const f32x2 ab = agg[((size_t)(b * 16 + cc)) * D + n * 128 + tid]; H = ab.x * H + ab.y; } cin[tid] = H; }
    __syncthreads();
    bf16x8 af[8];
#pragma unroll
    for (int ks = 0; ks < 8; ++ks) { const int row = 32 * wv + r32; af[ks] = *(const LAS bf16x8*)(At + row * 256 + (((2 * ks + hi) ^ (row & 15)) << 4)); }
#pragma unroll 1
    for (int q = 0; q < 4; ++q) {
        f32x16 aR = f32x16{}, aI = f32x16{};
#pragma unroll
        for (int ks = 0; ks < 8; ++ks) { const int brow = 32 * q + r32;
            const bf16x8 bR = *(const LAS bf16x8*)(Wt + brow * 256 + (((2 * ks + hi) ^ (brow & 15)) << 4));
            const bf16x8 bI = *(const LAS bf16x8*)(Wt + (brow + 128) * 256 + (((2 * ks + hi) ^ (brow & 15)) << 4));
            aR = __builtin_amdgcn_mfma_f32_32x32x16_bf16(af[ks], bR, aR, 0, 0, 0);
            aI = __builtin_amdgcn_mfma_f32_32x32x16_bf16(af[ks], bI, aI, 0, 0, 0); }
        const int chl = 32 * q + r32, ch = n * 128 + chl;
        const float br = b_rg[ch], bi = b_ig[ch], cl = -8.0f * log1pf(__expf(-lam[ch]));
        float h = 0.f, cum = 1.f;
#pragma unroll
        for (int r = 0; r < 16; ++r) {
            const int row = 32 * wv + att::crow(r, hi), tl = 32 * wv + 16 * hi + r;
            const float recv = bf2f(*(const LAS unsigned short*)(At + row * 256 + ((((chl >> 3) ^ (row & 15)) << 4)) + (chl & 7) * 2));
            const float rg = sigmoidf_(aR[r] + br), ig = sigmoidf_(aI[r] + bi);
            const float la = cl * rg, a = fast_exp2(LOG2E_ * la); float mult = sqrtf(fmaxf(1.0f - a * a, 0.f));
            if (c == 0 && tl == 0) mult = 1.0f;
            h = a * h + mult * ig * recv; cum *= a; aI[r] = h; aR[r] = cum;
        }
        const float pc = __shfl_xor(cum, 32), ph = __shfl_xor(h, 32);
        const float loc = hi ? pc : cum, loh = hi ? ph : h, hic = hi ? cum : pc, hih = hi ? h : ph;
        LAS f32x2* cq = comp + (q & 1) * 256;
        if (hi == 0) cq[wv * 32 + r32] = (f32x2){loc * hic, hic * loh + hih};
        __syncthreads();
        if (pass == 1) {
            if (tid < 32) { float A = 1.f, B = 0.f;
#pragma unroll
                for (int w = 0; w < 8; ++w) { const f32x2 ab = cq[w * 32 + tid]; B = ab.x * B + ab.y; A = ab.x * A; }
                agg[((size_t)(b * 16 + c)) * D + n * 128 + 32 * q + tid] = (f32x2){A, B}; }
        } else {
            float H = cin[chl];
            for (int w = 0; w < wv; ++w) { const f32x2 ab = cq[w * 32 + r32]; H = ab.x * H + ab.y; }
            if (hi) H = loc * H + loh;
            const bf16* zgb = ZG + rowbase * D + n * 128; bf16* catb = CAT + rowbase * DCAT + n * 128;
            const unsigned tl0 = 32 * wv + 16 * hi;
#pragma unroll
            for (int r = 0; r < 16; ++r) { const unsigned tl = tl0 + r;
                const float hv = aI[r] + aR[r] * H; const float gt = bf2f(zgb[tl * (unsigned)D + (unsigned)chl]);
                catb[tl * (unsigned)DCAT + (unsigned)chl] = (bf16)f2bf(hv * gt); }
        }
    }
}

__global__ void __launch_bounds__(NWAVES * 64, 2) yoco_fwd(Args args) {
    extern __shared__ __attribute__((aligned(16))) unsigned char lds_raw[];
    LAS unsigned char* lds = (LAS unsigned char*)lds_raw;
    const int tid = threadIdx.x, lane = tid & 63; const int wave = __builtin_amdgcn_readfirstlane(tid >> 6);
    const int G = gridDim.x, bx = blockIdx.x;
    const int gw = bx * NWAVES + wave, NGW = G * NWAVES;
    unsigned char* ws = args.ws;
    gu32* ctl = (gu32*)(ws + WS_CTL);
    for (int u = tid; u < (LDS_BYTES - LDSCTL_OFF) / 4; u += NWAVES * 64) ((LAS unsigned*)(lds + LDSCTL_OFF))[u] = 0u;
    __syncthreads();
    XcdBarrier bar = xcd_barrier_post((unsigned*)(ctl + CW_BAR), (volatile LAS unsigned*)(lds + LDSCTL_OFF) + 8);
    const int lo = args.ph_lo, hi_ph = args.ph_hi;
#ifndef PH_MASK
#define PH_MASK 0x1ffff
#endif
#define IN(k) ((((PH_MASK) >> (k)) & 1) && lo <= (k) && (k) < hi_ph)
#define SEAM(k) do { if (IN(k) && IN((k) + 1)) xcd_barrier(bar); } while (0)
#ifndef PROBE_DUP
#define PROBE_DUP (-1)
#endif
#define PH_BEGIN(k) if (IN(k)) for (int rep_ = 0; rep_ < ((PROBE_DUP) == (k) ? 2 : 1); ++rep_) if (rep_ == 0 || (xcd_barrier(bar), true))

    bf16* WZ = (bf16*)(ws + WS_WZ); bf16* WO0 = (bf16*)(ws + WS_WO0); bf16* W13 = (bf16*)(ws + WS_W13); bf16* W2 = (bf16*)(ws + WS_W2); bf16* WMKV = (bf16*)(ws + WS_WMKV);
    bf16* WKVQ = (bf16*)(ws + WS_WKVQ); bf16* WO1 = (bf16*)(ws + WS_WO1); bf16* WG = (bf16*)(ws + WS_WG); bf16* WM13 = (bf16*)(ws + WS_WM13); bf16* WM2 = (bf16*)(ws + WS_WM2);
    bf16* XB = (bf16*)(ws + WS_XB); bf16* MEMB = (bf16*)(ws + WS_MEMB); bf16* ZG = (bf16*)(ws + WS_ZG); bf16* U = (bf16*)(ws + WS_U); bf16* QM0 = (bf16*)(ws + WS_QM0);
    bf16* MKV = (bf16*)(ws + WS_MKV); f32x2* AGG = (f32x2*)(ws + WS_AGG); bf16* CAT = (bf16*)(ws + WS_CAT); float* Y = (float*)(ws + WS_Y);
    bf16* H1 = (bf16*)(ws + WS_H1); bf16* H2 = (bf16*)(ws + WS_H2); bf16* H3 = (bf16*)(ws + WS_H3); bf16* HID = (bf16*)(ws + WS_HID);
    bf16* KB = (bf16*)(ws + WS_K); bf16* VB = (bf16*)(ws + WS_V); bf16* QD = (bf16*)(ws + WS_QD); bf16* QM1 = (bf16*)(ws + WS_QM1); float* STASH = (float*)(ws + WS_STASH);
    bf16* AG = (bf16*)(ws + WS_AG); bf16* HIDM = (bf16*)(ws + WS_HIDM); bf16* Y2 = (bf16*)(ws + WS_Y2);
    int* RTE = (int*)(ws + RT_E); float* RTG = (float*)(ws + RT_G); int* WCNT = (int*)(ws + RT_WCNT); int* STOK = (int*)(ws + RT_STOK); float* SGATE = (float*)(ws + RT_SGATE);
    int* TDEST = (int*)(ws + RT_TDEST); int* TILEE = (int*)(ws + RT_TILEE); int* META = (int*)(ws + RT_META);
    const float* ln_g = args.in[IN_LN_G]; const float* ln_b = args.in[IN_LN_B];

    PH_BEGIN(0) {
        LAS float* scr = (LAS float*)(lds + RING_OFF + wave * 16384);
        int base = 0;
        p0_job(args.in[IN_A_W_IN], D, DZ, WZ, 0, 0, base, gw, NGW, scr, lane);
        p0_job(args.in[IN_A_W_OUT], DCAT, D, WO0, 0, 0, base, gw, NGW, scr, lane);
        p0_job(args.in[IN_FFN_W13], D, 2 * FF, W13, 1, 0, base, gw, NGW, scr, lane);
        p0_job(args.in[IN_FFN_W2], FF, D, W2, 0, 0, base, gw, NGW, scr, lane);
        p0_job(args.in[IN_MEM_W_KV], D, D, WMKV, 0, 0, base, gw, NGW, scr, lane);
        p0_job(args.in[IN_MEM_W_KV] + (size_t)D * D, D, D, WMKV, 0, D, base, gw, NGW, scr, lane);
        p0_job(args.in[IN_W_KV], D, 2 * D, WKVQ, 0, 0, base, gw, NGW, scr, lane);
        p0_job(args.in[IN_B_W_Q], D, DCAT, WKVQ, 0, 2 * D, base, gw, NGW, scr, lane);
        p0_job(args.in[IN_B_W_OUT], DCAT, D, WO1, 0, 0, base, gw, NGW, scr, lane);
        for (int n = 0; n < 8; ++n) {
            p0_job(args.in[IN_A_W_RG] + (size_t)n * 16384, 128, 128, WG, 0, n * 256, base, gw, NGW, scr, lane);
            p0_job(args.in[IN_A_W_IG] + (size_t)n * 16384, 128, 128, WG, 0, n * 256 + 128, base, gw, NGW, scr, lane);
        }
        for (int e = 0; e < NEXP; ++e) {
            p0_job(args.in[IN_MOE_W13] + (size_t)e * D * 2 * FF, D, 2 * FF, WM13 + (size_t)e * 2 * FF * D, 1, 0, base, gw, NGW, scr, lane);
            p0_job(args.in[IN_MOE_W2] + (size_t)e * FF * D, FF, D, WM2 + (size_t)e * D * FF, 0, 0, base, gw, NGW, scr, lane);
        }
        const size_t gtid = (size_t)bx * 512 + tid, nth = (size_t)G * 512;
        p0_cvt_rows(args.in[IN_X], XB, (size_t)M * D / 8, gtid, nth);
        p0_cvt_rows(args.in[IN_MEM], MEMB, (size_t)MEMROWS * D / 8, gtid, nth);
    }
    SEAM(0);

    PH_BEGIN(1) {
        { pg8::Gemm g{XB, WZ, M, DZ, D, 0}; pg8::StaticOrder S; S.init(M, DZ, G, bx);
          pg8::EpiSegT<0> E{ws};
          pg8::gemm_phase<pg8::EpiSegT<0>, pg8::StaticOrder, true, true>(lds + RING_OFF, g, S, E); }
        { pg8::Gemm g{MEMB, WMKV, MEMROWS, 2 * D, D, 0}; pg8::StaticOrder S; S.init(MEMROWS, 2 * D, G, bx);
          pg8::EpiSegT<1> E{ws};
          pg8::gemm_phase<pg8::EpiSegT<1>, pg8::StaticOrder, true, true>(lds + RING_OFF, g, S, E); }
    }
    SEAM(1);

    PH_BEGIN(2) {
        bool first = true;
        for (int L = bx; L < 1024; L += G) { const int pair = L & 63, c = L >> 6; scan_unit(1, pair >> 3, pair & 7, c, first || (G & 63), U, ZG, CAT, WG, AGG,
                args.in[IN_A_CONV_W], args.in[IN_A_CONV_B], args.in[IN_A_B_RG], args.in[IN_A_B_IG], args.in[IN_A_LAMBDA], lds); first = false; }
        __syncthreads();
        for (int L = bx; L < 512; L += G) { const int b = L >> 6, hd = (L >> 4) & 3, qb = L & 15; const size_t row0 = (size_t)b * T + qb * 256 + wave * 32;
            f32x16 o[4];
            att::attn_core<128, 128, false>(QM0 + row0 * 512 + hd * 128, 512, MKV + (size_t)b * MEMT * 2 * D + hd * 128, 2 * D, MKV + (size_t)b * MEMT * 2 * D + 512 + hd * 128, 2 * D, 4, 0, 0, 0.f, lds, o);
            att::store_o128(o, CAT + row0 * DCAT + D + hd * 128, DCAT, lds); }
    }
    SEAM(2);

    PH_BEGIN(3) {
        bool first = true;
        for (int L = bx; L < 1024; L += G) { const int pair = L & 63, c = L >> 6; scan_unit(2, pair >> 3, pair & 7, c, first || (G & 63), U, ZG, CAT, WG, AGG,
                args.in[IN_A_CONV_W], args.in[IN_A_CONV_B], args.in[IN_A_B_RG], args.in[IN_A_B_IG], args.in[IN_A_LAMBDA], lds); first = false; }
        __syncthreads();
    }
    SEAM(3);

    PH_BEGIN(4) { pg8::Gemm g{CAT, WO0, M, D, DCAT, 0}; pg8::StaticOrder S; S.init(M, D, G, bx); pg8::EpiF32 E{Y, D};
        pg8::gemm_phase<pg8::EpiF32, pg8::StaticOrder, true, true>(lds + RING_OFF, g, S, E); }
    SEAM(4);
    PH_BEGIN(5) { for (int m0 = gw * 4; m0 < M; m0 += NGW * 4) { f32x4 v[4][4]; ln_rows<4, true, false>(Y, args.in[IN_X], nullptr, nullptr, (size_t)m0, ln_g, ln_b, H1, nullptr, v, lane); } }
    SEAM(5);
    PH_BEGIN(6) { pg8::Gemm g{H1, W13, M, 2 * FF, D, 0}; pg8::StaticOrder S; S.init(M, 2 * FF, G, bx); pg8::EpiSwiGLU E{HID, FF};
        pg8::gemm_phase<pg8::EpiSwiGLU, pg8::StaticOrder, true, true>(lds + RING_OFF, g, S, E); }
    SEAM(6);
    PH_BEGIN(7) { pg8::Gemm g{HID, W2, M, D, FF, 0}; pg8::StaticOrder S; S.init(M, D, G, bx); pg8::EpiF32 E{Y, D};
        pg8::gemm_phase<pg8::EpiF32, pg8::StaticOrder, true, true>(lds + RING_OFF, g, S, E); }
    SEAM(7);
    PH_BEGIN(8) { for (int m0 = gw * 4; m0 < M; m0 += NGW * 4) { f32x4 v[4][4]; ln_rows<4, false, false>(Y, H1, nullptr, nullptr, (size_t)m0, ln_g + D, ln_b + D, H2, nullptr, v, lane); } }
    SEAM(8);
    PH_BEGIN(9) { pg8::Gemm g{H2, WKVQ, M, NKVQ, D, 0}; pg8::StaticOrder S; S.init(M, NKVQ, G, bx);
        pg8::EpiSegT<2> E{ws};
        pg8::gemm_phase<pg8::EpiSegT<2>, pg8::StaticOrder, true, true>(lds + RING_OFF, g, S, E); }
    SEAM(9);
    PH_BEGIN(10) {
        const float* lv = args.in[IN_B_LAMBDA];
        const float s1 = wave_sum(lv[lane] * lv[64 + lane]), s2 = wave_sum(lv[128 + lane] * lv[192 + lane]);
        const float lam = __expf(s1) - __expf(s2) + LAM_INIT;
        const int r32 = lane & 31, hi = lane >> 5;
        for (int L = bx; L < 1024; L += G) {
            const int i = L >> 8, w = L & 255, pair = w & 63, j = w >> 6, b = pair >> 3, h = pair & 7;
            const int qb = (i == 0) ? j : (i == 1) ? 7 - j : (i == 2) ? 8 + j : 15 - j;
            const size_t rowb = (size_t)b * T, row0 = rowb + qb * 256 + wave * 32;
            const float slope2 = exp2f(-(float)(h + 1)) * LOG2E;
            const int NT = (qb * 256 + 256) / 64, qpos0 = qb * 256 + wave * 32, qref = qb * 256 + 255;
            f32x4* st = (f32x4*)(STASH + (size_t)(bx * NWAVES + wave) * 4096) + lane * 16;
            f32x16 o[4];
#ifndef T10_NOFIRST
            att::attn_core<64, 128, true>(QD + row0 * D + h * 128 + 64, D, KB + rowb * D + h * 128 + 64, D, VB + rowb * D + h * 128, D, NT, qpos0, qref, slope2, lds, o);
#pragma unroll
            for (int d = 0; d < 4; ++d)
#pragma unroll
                for (int r4 = 0; r4 < 4; ++r4) st[d * 4 + r4] = (f32x4){o[d][4 * r4], o[d][4 * r4 + 1], o[d][4 * r4 + 2], o[d][4 * r4 + 3]};
#endif
            att::attn_core<64, 128, true>(QD + row0 * D + h * 128, D, KB + rowb * D + h * 128, D, VB + rowb * D + h * 128, D, NT, qpos0, qref, slope2, lds, o);
            VM_WAIT();
#ifndef T10_NOCOMB
            float gsub[4];
#pragma unroll
            for (int d = 0; d < 4; ++d) gsub[d] = args.in[IN_B_SUBLN][32 * d + r32] * (1.0f - LAM_INIT);
#pragma unroll
            for (int r4 = 0; r4 < 4; ++r4) {
                f32x4 s1[4];
#pragma unroll
                for (int d = 0; d < 4; ++d) s1[d] = st[d * 4 + r4];
#pragma unroll
                for (int k = 0; k < 4; ++k) { const int r = 4 * r4 + k; float ss = 0.f;
#pragma unroll
                    for (int d = 0; d < 4; ++d) { const float x = o[d][r] - lam * s1[d][k]; o[d][r] = x; ss += x * x; }
                    ss += __shfl_xor(ss, 1); ss += __shfl_xor(ss, 2); ss += __shfl_xor(ss, 4); ss += __shfl_xor(ss, 8); ss += __shfl_xor(ss, 16);
                    const float rinv = 1.0f / sqrtf(ss * (1.0f / 128.0f) + LN_EPS);
#pragma unroll
                    for (int d = 0; d < 4; ++d) o[d][r] *= rinv * gsub[d]; }
            }
#endif
            att::store_o128(o, CAT + row0 * DCAT + h * 128, DCAT, lds);
        }
        for (int L = bx; L < 512; L += G) { const int b = L >> 6, hd = (L >> 4) & 3, qb = L & 15; const size_t row0 = (size_t)b * T + qb * 256 + wave * 32;
            f32x16 o[4];
            att::attn_core<128, 128, false>(QM1 + row0 * 512 + hd * 128, 512, MKV + (size_t)b * MEMT * 2 * D + D + hd * 128, 2 * D, MKV + (size_t)b * MEMT * 2 * D + D + 512 + hd * 128, 2 * D, 4, 0, 0, 0.f, lds, o);
            att::store_o128(o, CAT + row0 * DCAT + D + hd * 128, DCAT, lds); }
        __syncthreads();
    }
    SEAM(10);
    PH_BEGIN(11) { pg8::Gemm g{CAT, WO1, M, D, DCAT, 0}; pg8::StaticOrder S; S.init(M, D, G, bx); pg8::EpiF32 E{Y, D};
        pg8::gemm_phase<pg8::EpiF32, pg8::StaticOrder, true, true>(lds + RING_OFF, g, S, E); }
    SEAM(11);
    PH_BEGIN(12) {
        LAS float* wr = (LAS float*)lds;
        for (int i = tid; i < D * NEXP / 4; i += 512) ((LAS f32x4*)wr)[i] = ((const f32x4*)args.in[IN_MOE_ROUTER])[i];
        __syncthreads();
        for (int slot = gw; slot < NSLOT; slot += NGW) {
            unsigned long long cnt64 = 0ull;
            for (int i4 = 0; i4 < 16; i4 += 4) { const int m0 = slot * 16 + i4; f32x4 v[4][4];
                ln_rows<4, false, false>(Y, H2, nullptr, nullptr, (size_t)m0, ln_g + 2 * D, ln_b + 2 * D, H3, nullptr, v, lane);
                float lg[4][8];
#pragma unroll
                for (int i = 0; i < 4; ++i)
#pragma unroll
                    for (int e = 0; e < 8; ++e) lg[i][e] = 0.f;
#pragma unroll
                for (int j = 0; j < 4; ++j)
#pragma unroll
                    for (int k = 0; k < 4; ++k) { const int col = 4 * lane + 256 * j + k; const f32x4 w0 = *(const LAS f32x4*)(wr + col * 8), w1 = *(const LAS f32x4*)(wr + col * 8 + 4);
#pragma unroll
                        for (int i = 0; i < 4; ++i) { const float x = v[i][j][k];
                            lg[i][0] += x * w0[0]; lg[i][1] += x * w0[1]; lg[i][2] += x * w0[2]; lg[i][3] += x * w0[3]; lg[i][4] += x * w1[0]; lg[i][5] += x * w1[1]; lg[i][6] += x * w1[2]; lg[i][7] += x * w1[3]; }
                        if (k == 3) __builtin_amdgcn_sched_barrier(0); }
#pragma unroll
                for (int o = 1; o < 64; o <<= 1)
#pragma unroll
                    for (int i = 0; i < 4; ++i)
#pragma unroll
                        for (int e = 0; e < 8; ++e) lg[i][e] += __shfl_xor(lg[i][e], o);
#pragma unroll
                for (int i = 0; i < 4; ++i) { const int m = m0 + i;
                    int e0 = 0; float v0 = lg[i][0];
#pragma unroll
                    for (int e = 1; e < 8; ++e) if (lg[i][e] > v0) { v0 = lg[i][e]; e0 = e; }
                    int e1 = -1; float v1 = -INFINITY;
#pragma unroll
                    for (int e = 0; e < 8; ++e) if (e != e0 && lg[i][e] > v1) { v1 = lg[i][e]; e1 = e; }
                    e0 = __builtin_amdgcn_readfirstlane(e0); e1 = __builtin_amdgcn_readfirstlane(e1);
                    const float g0 = 1.0f / (1.0f + __expf(v1 - v0));
                    if (lane == 0) { RTE[m] = e0 | (e1 << 8); RTG[2 * m] = g0; RTG[2 * m + 1] = 1.0f - g0; }
                    cnt64 += (1ull << (8 * e0)) + (1ull << (8 * e1)); }
            }
            if (lane < 8) WCNT[slot * 8 + lane] = (int)((cnt64 >> (8 * lane)) & 0xffull);
        }
        __syncthreads();
    }
    SEAM(12);
    PH_BEGIN(13) {
        LAS int* cnt = (LAS int*)lds; LAS int* part = cnt + NSLOT * 8; LAS int* meta = part + 512;
        for (int i = tid; i < NSLOT * 8; i += 512) cnt[i] = WCNT[i];
        __syncthreads();
        { const int e = tid & 7, j = tid >> 3; int s = 0; for (int k = 0; k < 32; ++k) s += cnt[(32 * j + k) * 8 + e]; part[j * 8 + e] = s; }
        __syncthreads();
        if (tid < 8) { int run = 0; for (int j = 0; j < 64; ++j) { const int t = part[j * 8 + tid]; part[j * 8 + tid] = run; run += t; } meta[tid] = run; }
        __syncthreads();
        if (tid == 0) { int ps = 0; for (int e = 0; e < 8; ++e) { meta[8 + e] = ps; ps += (meta[e] + 255) / 256 * 256; } meta[16] = ps / 256; }
        { const int e = tid & 7, j = tid >> 3; int run = part[j * 8 + e]; for (int k = 0; k < 32; ++k) { const int t = cnt[(32 * j + k) * 8 + e]; cnt[(32 * j + k) * 8 + e] = run; run += t; } }
        __syncthreads();
        if (bx == 0) { const int nt = meta[16]; if (tid == 0) META[0] = nt;
            for (int pm = tid; pm < 512; pm += 512) { int e = 7; for (int q = 7; q >= 0; --q) if (pm * 256 < meta[8 + q] + (meta[q] + 255) / 256 * 256) e = q; TILEE[pm] = (pm < nt) ? e : 0; } }
        for (int slot = gw; slot < NSLOT; slot += NGW) {
            unsigned long long lc = 0ull;
            for (int i = 0; i < 16; ++i) { const int m = slot * 16 + i; const int ee = __builtin_amdgcn_readfirstlane(RTE[m]);
#pragma unroll
                for (int k = 0; k < 2; ++k) { const int e = (ee >> (8 * k)) & 0xff; const int dest = meta[8 + e] + cnt[slot * 8 + e] + (int)((lc >> (8 * e)) & 0xffull); lc += 1ull << (8 * e);
                    if (lane == 0) { STOK[dest] = m; SGATE[dest] = RTG[2 * m + k]; TDEST[2 * m + k] = dest; }
                    const u32x4 a = *((const u32x4*)(H3 + (size_t)m * D) + lane), c2 = *((const u32x4*)(H3 + (size_t)m * D) + 64 + lane);
                    *((u32x4*)(AG + (size_t)dest * D) + lane) = a; *((u32x4*)(AG + (size_t)dest * D) + 64 + lane) = c2; }
            }
        }
        __syncthreads();
    }
    SEAM(13);
    PH_BEGIN(14) { const int nt = __builtin_amdgcn_readfirstlane(META[0]);
        pg8::Gemm g{AG, WM13, nt * 256, 2 * FF, D, (size_t)2 * FF * D * 2}; pg8::GroupedOrder S; S.init(nt * 256, 2 * FF, G, bx); S.tile_e = TILEE; pg8::EpiSwiGLU E{HIDM, FF};
        pg8::gemm_phase<pg8::EpiSwiGLU, pg8::GroupedOrder, true, true>(lds + RING_OFF, g, S, E); }
    SEAM(14);
    PH_BEGIN(15) { const int nt = __builtin_amdgcn_readfirstlane(META[0]);
        pg8::Gemm g{HIDM, WM2, nt * 256, D, FF, (size_t)D * FF * 2}; pg8::GroupedOrder S; S.init(nt * 256, D, G, bx); S.tile_e = TILEE; pg8::EpiRowScale E{Y2, D, SGATE};
        pg8::gemm_phase<pg8::EpiRowScale, pg8::GroupedOrder, true, true>(lds + RING_OFF, g, S, E); }
    SEAM(15);
    PH_BEGIN(16) { for (int m0 = gw * 4; m0 < M; m0 += NGW * 4) { f32x4 v[4][4]; ln_rows<4, false, true>(nullptr, H3, Y2, TDEST, (size_t)m0, ln_g + 3 * D, ln_b + 3 * D, nullptr, args.out, v, lane); } }
#undef IN
#undef SEAM
}

#ifndef MK_ONE_LAUNCH
#define MK_ONE_LAUNCH 1
#endif
extern "C" void kernel_launch(void* const* d_in, const int* in_sizes, int n_in, void* d_out, int out_size, void* d_ws, size_t ws_size, hipStream_t stream) {
    static int grid = 0;
    if (grid == 0) {
        if (n_in != N_IN || in_sizes[0] != M * D || out_size != M * D || ws_size < WS_END) { fprintf(stderr, "kernel_launch: unexpected shapes (n_in %d, in0 %d, out %d, ws %zu < %zu)\n", n_in, n_in > 0 ? in_sizes[0] : -1, out_size, ws_size, (size_t)WS_END); grid = -1; return; }
        int dev = 0, cus = 0, per_cu = 0;
        if (hipGetDevice(&dev) != hipSuccess || hipDeviceGetAttribute(&cus, hipDeviceAttributeMultiprocessorCount, dev) != hipSuccess) { grid = -1; return; }
        if (hipFuncSetAttribute((const void*)yoco_fwd, hipFuncAttributeMaxDynamicSharedMemorySize, LDS_BYTES) != hipSuccess) { fprintf(stderr, "kernel_launch: hipFuncSetAttribute failed\n"); grid = -1; return; }
        if (hipOccupancyMaxActiveBlocksPerMultiprocessor(&per_cu, (const void*)yoco_fwd, NWAVES * 64, LDS_BYTES) != hipSuccess || per_cu < 1) fprintf(stderr, "kernel_launch: occupancy query says %d\n", per_cu);
        (void)hipGetLastError();
        grid = cus;
    }
    if (grid < 0) return;
    (void)hipMemsetAsync((char*)d_ws + WS_CTL, 0, CTL_ZERO_BYTES, stream);
    Args a{};
    for (int i = 0; i < N_IN; ++i) a.in[i] = (const float*)d_in[i];
    a.out = (float*)d_out; a.ws = (unsigned char*)d_ws;
#if MK_ONE_LAUNCH
    a.ph_lo = 0; a.ph_hi = N_PHASES;
    hipLaunchKernelGGL(yoco_fwd, dim3(grid), dim3(NWAVES * 64), LDS_BYTES, stream, a);
#else
    for (int p = 0; p < N_PHASES; ++p) { a.ph_lo = p; a.ph_hi = p + 1; hipLaunchKernelGGL(yoco_fwd, dim3(grid), dim3(NWAVES * 64), LDS_BYTES, stream, a); }
#endif
    const hipError_t le = hipPeekAtLastError();
    if (le != hipSuccess) fprintf(stderr, "kernel_launch: launch failed: %s\n", hipGetErrorName(le));
}
```

```cpp
#include <hip/hip_runtime.h>
#include <cstdio>
#include <cstdint>

#define LAS __attribute__((address_space(3)))
#define GAS __attribute__((address_space(1)))
typedef unsigned short bf16;
typedef short bf16x8 __attribute__((ext_vector_type(8)));
typedef short s16x4 __attribute__((ext_vector_type(4)));
typedef float f32x2 __attribute__((ext_vector_type(2)));
typedef float f32x4 __attribute__((ext_vector_type(4)));
typedef float f32x16 __attribute__((ext_vector_type(16)));
typedef unsigned u32x2 __attribute__((ext_vector_type(2)));
typedef unsigned u32x4 __attribute__((ext_vector_type(4)));

__device__ __forceinline__ unsigned cvt_pk_bf16(float lo, float hi) { unsigned r; asm volatile("v_cvt_pk_bf16_f32 %0, %1, %2" : "=v"(r) : "v"(lo), "v"(hi)); return r; }
__device__ __forceinline__ float bf2f(unsigned short b) { return __uint_as_float(((unsigned)b) << 16); }
__device__ __forceinline__ float bflo(unsigned w) { return __uint_as_float(w << 16); }
__device__ __forceinline__ float bfhi(unsigned w) { return __uint_as_float(w & 0xffff0000u); }
__device__ __forceinline__ float fast_exp2(float x) { return __builtin_amdgcn_exp2f(x); }
__device__ __forceinline__ float fast_rcp(float x) { return __builtin_amdgcn_rcpf(x); }
__device__ __forceinline__ float sigmoidf_(float x) { return fast_rcp(1.0f + fast_exp2(-1.4426950408889634f * x)); }

namespace pg8 {
#define PG8_LAS __attribute__((address_space(3)))
typedef unsigned short bf16_t;
constexpr int BM = 256, BK = 64, HALF = 128, HTB = HALF * BK * 2  , STAGE_BYTES = 8 * HTB, NXCD = 8, WGM = 8;

__host__ __device__ __forceinline__ int lds_byte(int r, int c) { const int st = (r >> 4) * 2 + (c >> 5), rr = r & 15, cc = c & 31, ob = rr * 64 + cc * 2; return st * 1024 + (ob ^ (((ob >> 9) & 1) << 5)); }
__host__ __device__ __forceinline__ void stage_rc(int b, int& R, int& C) { const int st = b / 1024, sb = b % 1024, swz = sb ^ (((sb >> 9) & 1) << 5); R = (st >> 1) * 16 + swz / 64; C = (st & 1) * 32 + (swz % 64) / 2; }
__host__ __device__ __forceinline__ int perm32(int rho) { const int n = rho >> 4, i = rho & 15; return 8 * (i >> 2) + 4 * n + (i & 3); }

typedef int v8i_t __attribute__((ext_vector_type(8))); typedef int v4i_t __attribute__((ext_vector_type(4)));
__device__ __forceinline__ v8i_t pg8_cat(bf16x8 a, bf16x8 b) { const v4i_t x = __builtin_bit_cast(v4i_t, a), y = __builtin_bit_cast(v4i_t, b); return __builtin_shufflevector(x, y, 0, 1, 2, 3, 4, 5, 6, 7); }
struct Unit { int pm, pn, e; };
struct Gemm { const bf16_t* A; const bf16_t* Bt; int M, N, K; size_t estride; };

struct StaticOrder {
    int nM, nN, nwg, G, c;
    __host__ __device__ void init(int M, int N, int G_, int c_) { nM = M / BM; nN = N / BM; nwg = nM * nN; G = G_; c = c_; }
    __host__ __device__ bool next(int i, Unit& u) const {
        const long L = (long)i * G + c; if (L >= nwg) return false;
        int wgid = (int)L; { const int q = nwg / NXCD, r = nwg % NXCD, xcd = wgid % NXCD, off = wgid / NXCD; wgid = (xcd < r ? xcd * (q + 1) : r * (q + 1) + (xcd - r) * q) + off; }
        const int nig = WGM * nN, gid = wgid / nig, fm = gid * WGM, gsz = (nM - fm) < WGM ? (nM - fm) : WGM;
        u.pm = fm + ((wgid % nig) % gsz); u.pn = (wgid % nig) / gsz; u.e = 0; return true;
    }
    __device__ __forceinline__ void a_ready(const Unit&) const {}
    __device__ __forceinline__ void done(const Unit&) const {}
};
struct GroupedOrder : StaticOrder {
    const int* tile_e;
    __device__ bool next(int i, Unit& u) const { if (!StaticOrder::next(i, u)) return false; u.e = __builtin_amdgcn_readfirstlane(tile_e[u.pm]); return true; }
};

struct EpiF32 {
    static constexpr bool PERM = false, AFTER_DRAIN = false;
    float* C; int ldc;
    __device__ __forceinline__ void operator()(const f32x4 (&acc)[2][2][4][2], const Unit& u, int wr, int wc, int fr, int fq) const {
        const int row0 = u.pm * BM + wr * 64 + fr, col0 = u.pn * BM + wc * 32 + 4 * fq;
#pragma unroll
        for (int ai = 0; ai < 2; ++ai)
#pragma unroll
            for (int m = 0; m < 4; ++m) { float* rowp = C + (size_t)(row0 + ai * HALF + m * 16) * ldc + col0;
#pragma unroll
                for (int bj = 0; bj < 2; ++bj)
#pragma unroll
                    for (int n = 0; n < 2; ++n) *(f32x4*)(rowp + bj * HALF + n * 16) = acc[ai][bj][m][n]; }
    }
};
__device__ __forceinline__ float gelu_tanh(float x) { const float y = x * (1.0f + 0.044715f * x * x); return x * fast_rcp(1.0f + fast_exp2(-2.302208198f * y)); }
struct EpiSwiGLU {
    static constexpr bool PERM = true, AFTER_DRAIN = false;
    bf16_t* H; int ldh;
    __device__ __forceinline__ void operator()(const f32x4 (&acc)[2][2][4][2], const Unit& u, int wr, int wc, int fr, int fq) const {
        const int row0 = u.pm * BM + wr * 64 + fr, col0 = u.pn * HALF + wc * 32 + 8 * fq;
#pragma unroll
        for (int ai = 0; ai < 2; ++ai)
#pragma unroll
            for (int m = 0; m < 4; ++m) { bf16_t* rowp = H + (size_t)(row0 + ai * HALF + m * 16) * ldh + col0;
                f32x4 h0, h1;
#pragma unroll
                for (int j = 0; j < 4; ++j) { const float g0 = acc[ai][0][m][0][j], g1 = acc[ai][0][m][1][j];
                    h0[j] = g0 * fast_rcp(1.0f + fast_exp2(-1.4426950408889634f * g0)) * acc[ai][1][m][0][j];
                    h1[j] = g1 * fast_rcp(1.0f + fast_exp2(-1.4426950408889634f * g1)) * acc[ai][1][m][1][j]; }
                u32x4 w; w.x = cvt_pk_bf16(h0[0], h0[1]); w.y = cvt_pk_bf16(h0[2], h0[3]); w.z = cvt_pk_bf16(h1[0], h1[1]); w.w = cvt_pk_bf16(h1[2], h1[3]);
                *(u32x4*)rowp = w; }
    }
};
struct EpiRowScale {
    static constexpr bool PERM = true, AFTER_DRAIN = false;
    bf16_t* O; int ldc; const float* rs; float cs;
    __device__ __forceinline__ void operator()(const f32x4 (&acc)[2][2][4][2], const Unit& u, int wr, int wc, int fr, int fq) const {
        const int row0 = u.pm * BM + wr * 64 + fr, col0 = u.pn * BM + wc * 32 + 8 * fq;
#pragma unroll
        for (int ai = 0; ai < 2; ++ai)
#pragma unroll
            for (int m = 0; m < 4; ++m) { const int row = row0 + ai * HALF + m * 16; const float g = rs[row] * cs; bf16_t* rowp = O + (size_t)row * ldc + col0;
#pragma unroll
                for (int bj = 0; bj < 2; ++bj) { const f32x4 v0 = acc[ai][bj][m][0] * g, v1 = acc[ai][bj][m][1] * g;
                    u32x4 w; w.x = cvt_pk_bf16(v0[0], v0[1]); w.y = cvt_pk_bf16(v0[2], v0[3]); w.z = cvt_pk_bf16(v1[0], v1[1]); w.w = cvt_pk_bf16(v1[2], v1[3]);
                    *(u32x4*)(rowp + bj * HALF) = w; } }
    }
};


__device__ __forceinline__ unsigned cvt4_fp8(float a, float b, float c, float d) {
    a = fminf(fmaxf(a, -448.f), 448.f); b = fminf(fmaxf(b, -448.f), 448.f); c = fminf(fmaxf(c, -448.f), 448.f); d = fminf(fmaxf(d, -448.f), 448.f);
    int w = 0; w = __builtin_amdgcn_cvt_pk_fp8_f32(a, b, w, false); w = __builtin_amdgcn_cvt_pk_fp8_f32(c, d, w, true); return (unsigned)w; }
struct EpiSwiGLU8 {
    static constexpr bool PERM = true, AFTER_DRAIN = false;
    unsigned char* H; int ldh; float ws, hs;
    __device__ __forceinline__ void operator()(const f32x4 (&acc)[2][2][4][2], const Unit& u, int wr, int wc, int fr, int fq) const {
        const int row0 = u.pm * BM + wr * 64 + fr, col0 = u.pn * HALF + wc * 32 + 8 * fq;
#pragma unroll
        for (int ai = 0; ai < 2; ++ai)
#pragma unroll
            for (int m = 0; m < 4; ++m) { unsigned char* rowp = H + (size_t)(row0 + ai * HALF + m * 16) * ldh + col0;
                f32x4 h0, h1;
#pragma unroll
                for (int j = 0; j < 4; ++j) { const float g0 = acc[ai][0][m][0][j] * ws, g1 = acc[ai][0][m][1][j] * ws;
                    h0[j] = g0 * fast_rcp(1.0f + fast_exp2(-1.4426950408889634f * g0)) * (acc[ai][1][m][0][j] * (ws * hs));
                    h1[j] = g1 * fast_rcp(1.0f + fast_exp2(-1.4426950408889634f * g1)) * (acc[ai][1][m][1][j] * (ws * hs)); }
                u32x2 w; w.x = cvt4_fp8(h0[0], h0[1], h0[2], h0[3]); w.y = cvt4_fp8(h1[0], h1[1], h1[2], h1[3]);
                *(u32x2*)rowp = w; }
    }
};
template <class Epi, class Sched, bool ALIGN_EPI = false, bool SP2 = false, bool F8 = false>
__device__ __forceinline__ void gemm_phase(PG8_LAS unsigned char* lds, const Gemm g, const Sched& S, const Epi& E) {
    const int tid = threadIdx.x, wid = __builtin_amdgcn_readfirstlane(tid >> 6), lane = tid & 63, wr = wid >> 2, wc = wid & 3, fr = lane & 15, fq = lane >> 4;
    const int K = g.K, nt = K / BK;
    unsigned voffA[2], voffB[2];
#pragma unroll
    for (int i = 0; i < 2; ++i) { int R, C; stage_rc(tid * 16 + i * 8192, R, C); const int Rb = Epi::PERM ? ((R & ~31) + perm32(R & 31)) : R;
        voffA[i] = (unsigned)(R * K + C) * 2u; voffB[i] = (unsigned)(Rb * K + C) * 2u; }
    const size_t kstep = (size_t)(BK * 2);
    const size_t hstep = (size_t)HALF * K * 2;
    const size_t tstep = 2 * hstep;
    const unsigned ldsw = (unsigned)wid * 1024u;
    const int aoff = lds_byte(wr * 64 + fr, fq * 8), boff = lds_byte(wc * 32 + fr, fq * 8);
#define PG8_SA(b, h) (((b) * 2 + (h)) * HTB)
#define PG8_SB(b, h) ((4 + (b) * 2 + (h)) * HTB)
#define PG8_STAGE(bufoff, gbase, voff) do { _Pragma("unroll") for (int _i = 0; _i < 2; ++_i) \
        __builtin_amdgcn_global_load_lds((const unsigned*)((const char*)(gbase) + (voff)[_i]), (PG8_LAS unsigned*)(lds + (bufoff) + ldsw + _i * 8192), 16, 0, 0); } while (0)
#define PG8_LDA(dst, b, h) do { _Pragma("unroll") for (int m = 0; m < 4; ++m) { const bf16x8 x0_ = *(const PG8_LAS bf16x8*)(lds + PG8_SA(b, h) + aoff + m * 2048), x1_ = *(const PG8_LAS bf16x8*)(lds + PG8_SA(b, h) + aoff + m * 2048 + 1024); \
        if constexpr (F8) dst##8[m] = pg8_cat(x0_, x1_); else { dst[m][0] = x0_; dst[m][1] = x1_; } } } while (0)
#define PG8_LDB(dst, b, h) do { _Pragma("unroll") for (int n = 0; n < 2; ++n) { const bf16x8 x0_ = *(const PG8_LAS bf16x8*)(lds + PG8_SB(b, h) + boff + n * 2048), x1_ = *(const PG8_LAS bf16x8*)(lds + PG8_SB(b, h) + boff + n * 2048 + 1024); \
        if constexpr (F8) dst##8[n] = pg8_cat(x0_, x1_); else { dst[n][0] = x0_; dst[n][1] = x1_; } } } while (0)
#define PG8_MMA(ai, bj, At, Bt) do { __builtin_amdgcn_s_setprio(1); if constexpr (F8) { _Pragma("unroll") for (int m = 0; m < 4; ++m) _Pragma("unroll") for (int n = 0; n < 2; ++n) \
        asm volatile("v_mfma_scale_f32_16x16x128_f8f6f4 %0, %1, %2, %0, %3, %3 op_sel_hi:[0,0,0]" : "+v"(acc[ai][bj][m][n]) : "v"(Bt##8[n]), "v"(At##8[m]), "v"(f8scl)); } \
        else { _Pragma("unroll") for (int m = 0; m < 4; ++m) _Pragma("unroll") for (int n = 0; n < 2; ++n) _Pragma("unroll") for (int k = 0; k < 2; ++k) \
        acc[ai][bj][m][n] = __builtin_amdgcn_mfma_f32_16x16x32_bf16(Bt[n][k], At[m][k], acc[ai][bj][m][n], 0, 0, 0); } __builtin_amdgcn_s_setprio(0); } while (0)
#define PG8_WAIT_V(n) asm volatile("s_waitcnt vmcnt(" #n ")" ::: "memory")
#define PG8_WAIT_L(n) asm volatile("s_waitcnt lgkmcnt(" #n ")" ::: "memory")
#define PG8_BAR __builtin_amdgcn_s_barrier()
#define PG8_SCHED __builtin_amdgcn_sched_barrier(0)
    Unit cur, nxt; int ui = 0;
    if (!S.next(0, cur)) return;
    f32x4 acc[2][2][4][2];
#pragma unroll
    for (int a = 0; a < 2; ++a)
#pragma unroll
        for (int b = 0; b < 2; ++b)
#pragma unroll
            for (int m = 0; m < 4; ++m)
#pragma unroll
                for (int n = 0; n < 2; ++n) acc[a][b][m][n] = (f32x4){0.f, 0.f, 0.f, 0.f};
    bf16x8 At[4][2], B0[2][2], B1[2][2]; v8i_t At8[4], B08[2], B18[2]; const int f8scl = 0x7f7f7f7f;
    const char* cA = (const char*)g.A + (size_t)cur.pm * tstep; const char* cB = (const char*)g.Bt + ((size_t)cur.e * g.estride + (size_t)cur.pn * tstep);
    S.a_ready(cur);
    if constexpr (SP2) {
        PG8_STAGE(PG8_SB(0, 0), cB, voffB); PG8_STAGE(PG8_SB(0, 1), cB + hstep, voffB); PG8_STAGE(PG8_SA(0, 0), cA, voffA); PG8_STAGE(PG8_SA(0, 1), cA + hstep, voffA);
        if (wr == 1) PG8_BAR;
        PG8_WAIT_V(2); PG8_BAR;
        PG8_STAGE(PG8_SB(1, 0), cB + kstep, voffB); PG8_STAGE(PG8_SA(1, 0), cA + kstep, voffA); PG8_STAGE(PG8_SB(1, 1), cB + hstep + kstep, voffB);
        PG8_WAIT_V(6); PG8_BAR;
    } else {
        PG8_STAGE(PG8_SB(0, 0), cB, voffB); PG8_STAGE(PG8_SA(0, 0), cA, voffA); PG8_STAGE(PG8_SB(0, 1), cB + hstep, voffB); PG8_STAGE(PG8_SA(0, 1), cA + hstep, voffA);
        if (wr == 1) PG8_BAR;
        PG8_WAIT_V(4); PG8_BAR;
        PG8_STAGE(PG8_SB(1, 0), cB + kstep, voffB); PG8_STAGE(PG8_SA(1, 0), cA + kstep, voffA); PG8_STAGE(PG8_SB(1, 1), cB + hstep + kstep, voffB);
        PG8_WAIT_V(6); PG8_BAR;
    }
    for (;;) {
        const bool has_next = S.next(ui + 1, nxt);
        const char* nA = has_next ? (const char*)g.A + (size_t)nxt.pm * tstep : cA; const char* nB = has_next ? (const char*)g.Bt + ((size_t)nxt.e * g.estride + (size_t)nxt.pn * tstep) : cB;
        for (int t = 0; t < nt; t += 2) {
            const bool last = (t == nt - 2);
            const char* a1 = cA + (size_t)(t + 1) * kstep;
            const char* a2 = last ? nA : cA + (size_t)(t + 2) * kstep; const char* b2 = last ? nB : cB + (size_t)(t + 2) * kstep;
            const char* a3 = a2 + kstep; const char* b3 = b2 + kstep;
            if (last && has_next) S.a_ready(nxt);
            if constexpr (SP2) {
            PG8_LDB(B0, 0, 0); PG8_LDB(B1, 0, 1); PG8_SCHED; PG8_LDA(At, 0, 0); PG8_STAGE(PG8_SA(1, 1), a1 + hstep, voffA);
            PG8_WAIT_V(8); PG8_WAIT_L(0); PG8_BAR; PG8_MMA(0, 0, At, B0); PG8_MMA(0, 1, At, B1); PG8_BAR; PG8_SCHED;
            PG8_LDA(At, 0, 1); PG8_STAGE(PG8_SB(0, 0), b2, voffB); PG8_STAGE(PG8_SB(0, 1), b2 + hstep, voffB); PG8_STAGE(PG8_SA(0, 0), a2, voffA);
            PG8_WAIT_V(8); PG8_WAIT_L(0); PG8_BAR; PG8_MMA(1, 0, At, B0); PG8_MMA(1, 1, At, B1); PG8_BAR; PG8_SCHED;
            PG8_LDB(B0, 1, 0); PG8_LDB(B1, 1, 1); PG8_SCHED; PG8_LDA(At, 1, 0); PG8_STAGE(PG8_SA(0, 1), a2 + hstep, voffA);
            PG8_WAIT_V(8); PG8_WAIT_L(0); PG8_BAR; PG8_MMA(0, 0, At, B0); PG8_MMA(0, 1, At, B1); PG8_BAR; PG8_SCHED;
            PG8_LDA(At, 1, 1); PG8_STAGE(PG8_SB(1, 0), b3, voffB); PG8_STAGE(PG8_SB(1, 1), b3 + hstep, voffB); PG8_STAGE(PG8_SA(1, 0), a3, voffA);
            PG8_WAIT_V(8); PG8_WAIT_L(0); PG8_BAR; PG8_MMA(1, 0, At, B0); PG8_MMA(1, 1, At, B1); PG8_BAR; PG8_SCHED;
            } else {
            PG8_LDB(B0, 0, 0); PG8_SCHED; PG8_LDA(At, 0, 0); PG8_STAGE(PG8_SA(1, 1), a1 + hstep, voffA);
            PG8_WAIT_L(8); PG8_BAR; PG8_WAIT_L(0); PG8_MMA(0, 0, At, B0); PG8_BAR; PG8_SCHED;
            PG8_LDB(B1, 0, 1); PG8_STAGE(PG8_SB(0, 0), b2, voffB);
            PG8_BAR; PG8_WAIT_L(0); PG8_MMA(0, 1, At, B1); PG8_BAR;
            PG8_LDA(At, 0, 1); PG8_STAGE(PG8_SA(0, 0), a2, voffA);
            PG8_BAR; PG8_WAIT_L(0); PG8_MMA(1, 0, At, B0); PG8_BAR; PG8_SCHED;
            PG8_STAGE(PG8_SB(0, 1), b2 + hstep, voffB);
            PG8_WAIT_V(6); PG8_BAR; PG8_MMA(1, 1, At, B1); PG8_BAR;
            PG8_LDB(B0, 1, 0); PG8_SCHED; PG8_LDA(At, 1, 0); PG8_STAGE(PG8_SA(0, 1), a2 + hstep, voffA);
            PG8_WAIT_L(8); PG8_BAR; PG8_WAIT_L(0); PG8_MMA(0, 0, At, B0); PG8_BAR; PG8_SCHED;
            PG8_LDB(B1, 1, 1); PG8_STAGE(PG8_SB(1, 0), b3, voffB);
            PG8_BAR; PG8_WAIT_L(0); PG8_MMA(0, 1, At, B1); PG8_BAR;
            PG8_LDA(At, 1, 1); PG8_STAGE(PG8_SA(1, 0), a3, voffA);
            PG8_BAR; PG8_WAIT_L(0); PG8_MMA(1, 0, At, B0); PG8_BAR; PG8_SCHED;
            PG8_STAGE(PG8_SB(1, 1), b3 + hstep, voffB);
            PG8_WAIT_V(6); PG8_BAR; PG8_MMA(1, 1, At, B1); PG8_BAR;
            }
        }
        if constexpr (F8) { _Pragma("unroll") for (int a_ = 0; a_ < 2; ++a_) _Pragma("unroll") for (int b_ = 0; b_ < 2; ++b_)
            asm volatile("s_nop 15\n\ts_nop 7" : "+v"(acc[a_][b_][0][0]), "+v"(acc[a_][b_][0][1]), "+v"(acc[a_][b_][1][0]), "+v"(acc[a_][b_][1][1]), "+v"(acc[a_][b_][2][0]), "+v"(acc[a_][b_][2][1]), "+v"(acc[a_][b_][3][0]), "+v"(acc[a_][b_][3][1])); }
        if constexpr (ALIGN_EPI) { if (wr == 0) PG8_BAR; }
        if constexpr (!Epi::AFTER_DRAIN) { E(acc, cur, wr, wc, fr, fq); S.done(cur); }
        if (!has_next) break;
#pragma unroll
        for (int a = 0; a < 2; ++a)
#pragma unroll
            for (int b = 0; b < 2; ++b)
#pragma unroll
                for (int m = 0; m < 4; ++m)
#pragma unroll
                    for (int n = 0; n < 2; ++n) acc[a][b][m][n] = (f32x4){0.f, 0.f, 0.f, 0.f};
        cur = nxt; cA = nA; cB = nB; ++ui;
        if constexpr (ALIGN_EPI) { if (wr == 1) PG8_BAR; }
    }
    PG8_WAIT_V(0);
    if constexpr (!ALIGN_EPI) { if (wr == 0) PG8_BAR; }
    PG8_BAR;
    if constexpr (Epi::AFTER_DRAIN) { E.fused(acc, cur, wr, wc, fr, fq, lds, wid, lane); S.done(cur); }
#undef PG8_SA
#undef PG8_SB
#undef PG8_STAGE
#undef PG8_LDA
#undef PG8_LDB
#undef PG8_MMA
#undef PG8_WAIT_V
#undef PG8_WAIT_L
#undef PG8_BAR
#undef PG8_SCHED
}
}

namespace att {
typedef short v4i16_t __attribute__((ext_vector_type(4)));
constexpr int LDS_K = 0, LDS_V = 16384, LDS_WS = 32768, LDS_OST = 36864, LDS_BYTES = LDS_OST + 8 * 8192;
__device__ __forceinline__ int crow(int r, int hi) { return (r & 3) + 8 * (r >> 2) + 4 * hi; }
__device__ __forceinline__ s16x4 vtr(const LAS unsigned char* p) { return __builtin_bit_cast(s16x4, __builtin_amdgcn_ds_read_tr16_b64_v4i16((LAS v4i16_t*)p)); }
__device__ __forceinline__ float xhalf_max(float m) { auto rr = __builtin_amdgcn_permlane32_swap(__float_as_uint(m), __float_as_uint(m), false, false); return fmaxf(__uint_as_float(rr[0]), __uint_as_float(rr[1])); }
__device__ __forceinline__ float xhalf_sum(float m) { auto rr = __builtin_amdgcn_permlane32_swap(__float_as_uint(m), __float_as_uint(m), false, false); return __uint_as_float(rr[0]) + __uint_as_float(rr[1]); }

template <int DQK, int DV, bool CAUSAL>
__device__ __forceinline__ void attn_core(const bf16* Qw, int ldq, const bf16* Kh, int ldk, const bf16* Vh, int ldv, int NT, int qpos0, int qref, float slope2,
                                          LAS unsigned char* shm, f32x16 (&o)[DV / 32]) {
    const int tid = threadIdx.x, lane = tid & 63, r32 = lane & 31, hi = lane >> 5; const int wid = __builtin_amdgcn_readfirstlane(tid >> 6);
    LAS float* wsf = (LAS float*)(shm + LDS_WS) + wid * 64;
    constexpr int NKC = DQK / 64, NVP = DV / 64, ND = DQK / 16, NO = DV / 32;
    bf16x8 qr[ND];
#pragma unroll
    for (int d0 = 0; d0 < ND; ++d0) qr[d0] = *(const bf16x8*)(Qw + (size_t)r32 * ldq + d0 * 16 + hi * 8);
    u32x4 kreg[NKC], vreg[NVP];
#pragma unroll
    for (int i = 0; i < NKC; ++i) kreg[i] = *(const u32x4*)(Kh + (size_t)lane * ldk + (wid + 8 * i) * 8);
#pragma unroll
    for (int i = 0; i < NVP; ++i) { const int pc = wid + 8 * i; vreg[i] = *(const u32x4*)(Vh + (size_t)(16 * (pc & 3) + (lane >> 2)) * ldv + (pc >> 2) * 32 + (lane & 3) * 8); }
    float m = -1e30f, l = 0.f;
#pragma unroll
    for (int d = 0; d < NO; ++d) o[d] = f32x16{};
    const LAS unsigned char* kb = shm + LDS_K + hi * 1024 + r32 * 16;
    const LAS unsigned char* vp = shm + LDS_V + ((lane >> 4) & 1) * 32 + (lane & 3) * 8 + (4 * hi + ((lane & 15) >> 2)) * 64;
    for (int t = 0; t < NT; ++t) {
        __syncthreads();
#pragma unroll
        for (int i = 0; i < NKC; ++i) *(LAS u32x4*)(shm + LDS_K + (wid + 8 * i) * 1024 + lane * 16) = kreg[i];
#pragma unroll
        for (int i = 0; i < NVP; ++i) *(LAS u32x4*)(shm + LDS_V + (wid + 8 * i) * 1024 + lane * 16) = vreg[i];
        if (t + 1 < NT) {
#pragma unroll
            for (int i = 0; i < NKC; ++i) kreg[i] = *(const u32x4*)(Kh + (size_t)(64 * (t + 1) + lane) * ldk + (wid + 8 * i) * 8);
#pragma unroll
            for (int i = 0; i < NVP; ++i) { const int pc = wid + 8 * i; vreg[i] = *(const u32x4*)(Vh + (size_t)(64 * (t + 1) + 16 * (pc & 3) + (lane >> 2)) * ldv + (pc >> 2) * 32 + (lane & 3) * 8); }
        }
        __syncthreads();
        const bool active = !CAUSAL || (64 * t <= qpos0 + 31);
        if (active) {
            f32x16 p0, p1;
#pragma unroll
            for (int r = 0; r < 16; ++r) { const float bz = slope2 * (float)(64 * t + crow(r, hi) - qref); p0[r] = bz; p1[r] = bz + 32.0f * slope2; }
#pragma unroll
            for (int d0 = 0; d0 < ND; ++d0) {
                const bf16x8 b0 = *(const LAS bf16x8*)(kb + d0 * 2048), b1 = *(const LAS bf16x8*)(kb + d0 * 2048 + 512);
                p0 = __builtin_amdgcn_mfma_f32_32x32x16_bf16(b0, qr[d0], p0, 0, 0, 0);
                p1 = __builtin_amdgcn_mfma_f32_32x32x16_bf16(b1, qr[d0], p1, 0, 0, 0);
            }
            if (CAUSAL && (64 * t + 63 > qpos0)) {
                const int q = qpos0 + r32;
#pragma unroll
                for (int r = 0; r < 16; ++r) { const int kv = 64 * t + crow(r, hi); if (kv > q) p0[r] = -INFINITY; if (kv + 32 > q) p1[r] = -INFINITY; }
            }
            float rm = fmaxf(p0[0], p1[0]);
#pragma unroll
            for (int r = 1; r < 16; ++r) rm = fmaxf(rm, fmaxf(p0[r], p1[r]));
            rm = xhalf_max(rm);
            const float mn = fmaxf(m, rm), alpha = fast_exp2(m - mn); m = mn;
            float s = 0.f;
#pragma unroll
            for (int r = 0; r < 16; ++r) { p0[r] = fast_exp2(p0[r] - mn); p1[r] = fast_exp2(p1[r] - mn); s += p0[r] + p1[r]; }
            l = l * alpha + s;
            if (hi == 0) wsf[r32] = alpha;
#pragma unroll
            for (int r = 0; r < 16; ++r) { const float f = wsf[crow(r, hi)];
#pragma unroll
                for (int d = 0; d < NO; ++d) o[d][r] *= f; }
            bf16x8 pa[4];
#pragma unroll
            for (int ks = 0; ks < 4; ++ks) { u32x4 w;
#pragma unroll
                for (int j = 0; j < 4; ++j) { const int b = 8 * (ks & 1) + 2 * j; w[j] = (ks < 2) ? cvt_pk_bf16(p0[b], p0[b + 1]) : cvt_pk_bf16(p1[b], p1[b + 1]); }
                pa[ks] = __builtin_bit_cast(bf16x8, w); }
#pragma unroll
            for (int d0 = 0; d0 < NO; ++d0) {
#pragma unroll
                for (int ks = 0; ks < 4; ++ks) {
                    const s16x4 lo = vtr(vp + d0 * 4096 + ks * 1024), hh = vtr(vp + d0 * 4096 + ks * 1024 + 512);
                    const bf16x8 vf = (bf16x8){lo[0], lo[1], lo[2], lo[3], hh[0], hh[1], hh[2], hh[3]};
                    o[d0] = __builtin_amdgcn_mfma_f32_32x32x16_bf16(pa[ks], vf, o[d0], 0, 0, 0);
                }
                __builtin_amdgcn_sched_barrier(0);
            }
        }
    }
    l = xhalf_sum(l);
    if (hi == 0) wsf[32 + r32] = fast_rcp(l);
#pragma unroll
    for (int r = 0; r < 16; ++r) { const float f = wsf[32 + crow(r, hi)];
#pragma unroll
        for (int d = 0; d < NO; ++d) o[d][r] *= f; }
}
__device__ __forceinline__ void store_o128(const f32x16 (&o)[4], bf16* Ow, int ldo, LAS unsigned char* shm) {
    const int tid = threadIdx.x, lane = tid & 63, r32 = lane & 31, hi = lane >> 5; const int wid = __builtin_amdgcn_readfirstlane(tid >> 6);
    LAS bf16* stg = (LAS bf16*)(shm + LDS_OST + wid * 8192);
#pragma unroll
    for (int r = 0; r < 16; ++r) { const int orow = crow(r, hi);
#pragma unroll
        for (int d0 = 0; d0 < 4; ++d0) stg[orow * 128 + d0 * 32 + r32] = (bf16)(cvt_pk_bf16(o[d0][r], 0.f) & 0xffffu); }
#pragma unroll
    for (int i = 0; i < 8; ++i) { const int row = i * 4 + (lane >> 4), ch = lane & 15; const u32x4 v = *(const LAS u32x4*)(stg + row * 128 + ch * 8); *(u32x4*)(Ow + (size_t)row * ldo + ch * 8) = v; }
}
}

constexpr int NWAVES = 8;
constexpr int BATCH = 8, T = 4096, D = 1024, M = BATCH * T;
constexpr int DZ = 2560, DCAT = 1536, FF = 3584, NKVQ = 3584, NEXP = 8, MEMT = 256, MEMROWS = BATCH * MEMT;
constexpr int MOE_ROWS = 2 * M + NEXP * 256;
constexpr int NSLOT = M / 16;
constexpr float LN_EPS = 1e-5f, DN_ALPHA = 1.41421356237f;
constexpr float LOG2E = 1.4426950408889634f;
constexpr float C2Q = 0.125f * LOG2E;
constexpr float C2M = 0.08838834764831845f * LOG2E;
constexpr float WSC13 = 32.f, WSC2 = 128.f, HSC = 8.f;
constexpr float LAM_INIT = 0.35550906759f;

constexpr size_t MiB = 1u << 20;
constexpr size_t WS_CTL = 0, CTL_ZERO_BYTES = 64 * 1024;
constexpr size_t WS_WZ = 1 * MiB, WS_WO0 = 6 * MiB, WS_W13 = 9 * MiB, WS_W2 = 23 * MiB, WS_WMKV = 30 * MiB, WS_WKVQ = 34 * MiB, WS_WO1 = 41 * MiB, WS_WG = 44 * MiB,
                 WS_WM13 = 45 * MiB, WS_WM2 = 157 * MiB;
constexpr size_t WS_ROUTE = 213 * MiB;
constexpr size_t RT_E = WS_ROUTE, RT_G = RT_E + (size_t)M * 4, RT_WCNT = RT_G + (size_t)M * 8, RT_STOK = RT_WCNT + NSLOT * 8 * 4, RT_SGATE = RT_STOK + (size_t)MOE_ROWS * 4,
                 RT_TDEST = RT_SGATE + (size_t)MOE_ROWS * 4, RT_TILEE = RT_TDEST + (size_t)M * 8, RT_META = RT_TILEE + 2048, RT_END = RT_META + 256;
static_assert(RT_END <= 215 * MiB, "route region");
constexpr size_t WS_AGG = 215 * MiB, WS_MKV = 216 * MiB, WS_MEMB = 224 * MiB;
constexpr size_t WS_H3 = 228 * MiB, WS_STASH = 228 * MiB;
constexpr size_t WS_BIG = 292 * MiB;
constexpr size_t WS_XB = WS_BIG, WS_ZG = WS_BIG + 64 * MiB, WS_U = WS_BIG + 128 * MiB, WS_QM0 = WS_BIG + 192 * MiB;
constexpr size_t WS_CAT = WS_BIG + 224 * MiB, WS_Y = WS_BIG + 320 * MiB, WS_H1 = WS_BIG + 448 * MiB, WS_H2 = WS_BIG + 512 * MiB;
constexpr size_t WS_HID = WS_BIG, WS_K = WS_BIG, WS_V = WS_BIG + 64 * MiB, WS_QD = WS_BIG + 128 * MiB, WS_QM1 = WS_BIG + 192 * MiB;
constexpr size_t WS_HIDM = WS_BIG, WS_AG = WS_BIG + 462 * MiB, WS_Y2 = WS_AG, WS_END = WS_AG + 132 * MiB;
static_assert((size_t)MOE_ROWS * FF * 2 <= 462 * MiB && (size_t)MOE_ROWS * D * 2 <= 132 * MiB, "moe buffers");
constexpr int CW_TMO = 0, CW_CODE = 1, CW_BAR = 4096;

constexpr int RING_OFF = 0, RING_BYTES = 131072, XTRA_OFF = 131072, XTRA_BYTES = 24576, LDSCTL_OFF = XTRA_OFF + XTRA_BYTES, LDS_BYTES = LDSCTL_OFF + 512;

typedef GAS unsigned gu32;
#define RLX_AGENT __ATOMIC_RELAXED, __HIP_MEMORY_SCOPE_AGENT
#define LDS_WAIT() asm volatile("s_waitcnt lgkmcnt(0)" ::: "memory")
#define VM_WAIT() asm volatile("s_waitcnt vmcnt(0)" ::: "memory")
__device__ __forceinline__ unsigned f2bf(float f) { unsigned u = __builtin_bit_cast(unsigned, f); return (u + 0x7fffu + ((u >> 16) & 1u)) >> 16; }
__device__ __forceinline__ unsigned pk2(float lo, float hi) { return f2bf(lo) | (f2bf(hi) << 16); }
__device__ __forceinline__ float wave_sum(float v) {
#pragma unroll
    for (int o = 1; o < 64; o <<= 1) v += __shfl_xor(v, o);
    return v;
}

#define XB_TMO      128
#define XB_XCNT(j)  (256  + 64 * (j))
#define XB_XSUB(j)  (1280 + 64 * (j))
#define XB_XGEN(j)  (2304 + 64 * (j))
#define XB_TOP      3328
#define XB_TOPGEN   3392
#define XCD_BAR_WORDS 3456
#define XB_SPIN_CAP (1u << 18)

__device__ __forceinline__ unsigned xb_ld(unsigned* p)              { return __hip_atomic_load(p, __ATOMIC_RELAXED, __HIP_MEMORY_SCOPE_AGENT); }
__device__ __forceinline__ unsigned xb_add(unsigned* p, unsigned v) { return __hip_atomic_fetch_add(p, v, __ATOMIC_RELAXED, __HIP_MEMORY_SCOPE_AGENT); }
__device__ __forceinline__ unsigned xb_xcc_id() { return (unsigned)__builtin_amdgcn_s_getreg((3 << 11) | 20) & 0xFu; }
#define XB_SPIN(cond, bar) do { unsigned _sp = 0; while (cond) { __builtin_amdgcn_s_sleep(1); \
    if ((++_sp & 255u) == 0u) { if (xb_ld(&(bar)[XB_TMO])) break; if (_sp > XB_SPIN_CAP) { atomicAdd(&(bar)[XB_TMO], 1u); break; } } } } while (0)

struct XcdBarrier {
    unsigned* bar; unsigned x;
    volatile LAS unsigned* st;
};

__device__ __forceinline__ XcdBarrier xcd_barrier_post(unsigned* bar, volatile LAS unsigned* st) {
    XcdBarrier b; b.bar = bar; b.x = xb_xcc_id(); b.st = st;
    if (threadIdx.x == 0) (void)xb_add(&bar[XB_XCNT(b.x)], 1u);
    return b;
}
__device__ __forceinline__ void xcd_barrier_complete(unsigned* bar, unsigned x, unsigned& nloc, unsigned& nx) {
    const unsigned G = gridDim.x * gridDim.y * gridDim.z;
    unsigned sum, cnt, mine, sp = 0u;
    for (;;) {
        sum = 0u; cnt = 0u; mine = 0u;
#pragma unroll
        for (unsigned j = 0; j < 16; ++j) { const unsigned c = xb_ld(&bar[XB_XCNT(j)]); sum += c; cnt += (c > 0u) ? 1u : 0u; mine = (j == x) ? c : mine; }
        if (sum == G) break;
        __builtin_amdgcn_s_sleep(1);
        if ((++sp & 255u) == 0u) { if (xb_ld(&bar[XB_TMO])) break; if (sp > XB_SPIN_CAP) { atomicAdd(&bar[XB_TMO], 1u); break; } }
    }
    nloc = mine > 0u ? mine : 1u; nx = cnt > 0u ? cnt : 1u;
}

__device__ __forceinline__ void xcd_barrier(const XcdBarrier& b) {
    asm volatile("s_waitcnt vmcnt(0)" ::: "memory");
    __syncthreads();
    if (threadIdx.x == 0) {
        unsigned* bar = b.bar;
        __builtin_amdgcn_s_waitcnt(0);
        unsigned nloc = b.st[0], nx = b.st[1];
        if (nloc == 0u) { xcd_barrier_complete(bar, b.x, nloc, nx); b.st[0] = nloc; b.st[1] = nx; }
        const unsigned old = xb_add(&bar[XB_XSUB(b.x)], 1u);
        const unsigned gen = old / nloc;
        if (old + 1u == (gen + 1u) * nloc) {
            __builtin_amdgcn_fence(__ATOMIC_RELEASE, "agent");
            asm volatile("s_waitcnt vmcnt(0)" ::: "memory");
            const unsigned og = xb_add(&bar[XB_TOP], 1u);
            const unsigned tg = og / nx;
            if (og + 1u == (tg + 1u) * nx) xb_add(&bar[XB_TOPGEN], 1u);
            else XB_SPIN(xb_ld(&bar[XB_TOPGEN]) == tg, bar);
            __builtin_amdgcn_fence(__ATOMIC_ACQUIRE, "agent");
            xb_add(&bar[XB_XGEN(b.x)], 1u);
            asm volatile("s_waitcnt vmcnt(0)" ::: "memory");
        } else {
            XB_SPIN(xb_ld(&bar[XB_XGEN(b.x)]) == gen, bar);
            __builtin_amdgcn_fence(__ATOMIC_ACQUIRE, "agent");
            asm volatile("s_waitcnt vmcnt(0)" ::: "memory");
        }
    }
    __syncthreads();
}

enum { IN_X = 0, IN_MEM, IN_A_W_IN, IN_A_CONV_W, IN_A_CONV_B, IN_A_W_RG, IN_A_B_RG, IN_A_W_IG, IN_A_B_IG, IN_A_LAMBDA, IN_A_W_OUT, IN_W_KV, IN_B_W_Q, IN_B_LAMBDA, IN_B_SUBLN,
       IN_B_W_OUT, IN_MEM_W_KV, IN_FFN_W13, IN_FFN_W2, IN_MOE_ROUTER, IN_MOE_W13, IN_MOE_W2, IN_LN_G, IN_LN_B, N_IN };
struct Args { const float* in[N_IN]; float* out; unsigned char* ws; int ph_lo, ph_hi; };
constexpr int N_PHASES = 17;


namespace pg8 {
template <int MODE> struct EpiSegT {
    static constexpr bool PERM = true, AFTER_DRAIN = false;
    unsigned char* ws;
    __device__ __forceinline__ void operator()(const f32x4 (&acc)[2][2][4][2], const Unit& u, int wr, int wc, int fr, int fq) const {
        size_t off; int ldc, ts; float scl; bool act = false;
        if (MODE == 0) { if (u.pn < 4) { off = WS_ZG; ldc = D; ts = 0; scl = 1.f; act = true; } else if (u.pn < 8) { off = WS_U; ldc = D; ts = 4; scl = 1.f; } else { off = WS_QM0; ldc = 512; ts = 8; scl = C2M; } }
        else if (MODE == 1) { off = WS_MKV; ldc = 2 * D; ts = 0; scl = 1.f; }
        else { if (u.pn < 4) { off = WS_K; ldc = D; ts = 0; scl = 1.f; } else if (u.pn < 8) { off = WS_V; ldc = D; ts = 4; scl = 1.f; } else if (u.pn < 12) { off = WS_QD; ldc = D; ts = 8; scl = C2Q; } else { off = WS_QM1; ldc = 512; ts = 12; scl = C2M; } }
        bf16_t* base = (bf16_t*)(ws + off);
        const int row0 = u.pm * BM + wr * 64 + fr, col0 = (u.pn - ts) * BM + wc * 32 + 8 * fq;
#pragma unroll
        for (int ai = 0; ai < 2; ++ai)
#pragma unroll
            for (int m = 0; m < 4; ++m) { bf16_t* rowp = base + (size_t)(row0 + ai * HALF + m * 16) * ldc + col0;
#pragma unroll
                for (int bj = 0; bj < 2; ++bj) { f32x4 v0 = acc[ai][bj][m][0], v1 = acc[ai][bj][m][1];
                    if (act) {
#pragma unroll
                        for (int j = 0; j < 4; ++j) { v0[j] = gelu_tanh(v0[j]); v1[j] = gelu_tanh(v1[j]); } }
                    v0 = v0 * scl; v1 = v1 * scl;
                    u32x4 w; w.x = cvt_pk_bf16(v0[0], v0[1]); w.y = cvt_pk_bf16(v0[2], v0[3]); w.z = cvt_pk_bf16(v1[0], v1[1]); w.w = cvt_pk_bf16(v1[2], v1[3]);
                    *(u32x4*)(rowp + bj * HALF) = w; } }
    }
};
}

__device__ __forceinline__ void p0_transpose_item(const float* W, int K, int N, bf16* WT, int k0, int n0, int drow0, LAS float* scr, int lane) {
    float v[32];
#pragma unroll
    for (int i = 0; i < 32; ++i) { const int kk = 2 * i + (lane >> 5); v[i] = W[(size_t)(k0 + kk) * N + n0 + (lane & 31)]; }
#pragma unroll
    for (int i = 0; i < 32; ++i) { const int kk = 2 * i + (lane >> 5); scr[kk * 33 + (lane & 31)] = v[i]; }
    LDS_WAIT(); asm volatile("" ::: "memory");
    const int c = lane & 7;
#pragma unroll
    for (int j = 0; j < 4; ++j) { const int n = (lane >> 3) + 8 * j; const LAS float* s = scr + (8 * c) * 33 + n;
        u32x4 o; o.x = pk2(s[0 * 33], s[1 * 33]); o.y = pk2(s[2 * 33], s[3 * 33]); o.z = pk2(s[4 * 33], s[5 * 33]); o.w = pk2(s[6 * 33], s[7 * 33]);
        *(u32x4*)(WT + (size_t)(drow0 + n) * K + k0 + 8 * c) = o; }
    LDS_WAIT(); asm volatile("" ::: "memory");
}
__device__ __forceinline__ void p0_job(const float* W, int K, int N, bf16* WT, int mode, int row_off, int& base, int gw, int NGW, LAS float* scr, int lane) {
    const int nblk = N / 32, nitems = (K / 64) * nblk;
    int it0 = (gw - (base % NGW) + NGW) % NGW;
    for (int it = it0; it < nitems; it += NGW) {
        const int kb = it / nblk, nb = it % nblk, n0 = 32 * nb;
        int drow0;
        if (mode == 0) drow0 = row_off + n0;
        else { const int isu = n0 >= FF, nn = isu ? n0 - FF : n0; drow0 = 256 * (nn / 128) + 128 * isu + (nn % 128); }
        p0_transpose_item(W, K, N, WT, 64 * kb, n0, drow0, scr, lane);
    }
    base += nitems;
}

__device__ __forceinline__ void p0_transpose_item_f8(const float* W, int K, int N, unsigned char* WT, int k0, int n0, int drow0, float sc, LAS float* scr, int lane) {
    float v[32];
#pragma unroll
    for (int i = 0; i < 32; ++i) { const int kk = 2 * i + (lane >> 5); v[i] = W[(size_t)(k0 + kk) * N + n0 + (lane & 31)]; }
#pragma unroll
    for (int i = 0; i < 32; ++i) { const int kk = 2 * i + (lane >> 5); scr[kk * 33 + (lane & 31)] = v[i]; }
    LDS_WAIT(); asm volatile("" ::: "memory");
    const int n = lane >> 1, hf = lane & 1; const LAS float* s = scr + (32 * hf) * 33 + n;
    u32x4 o0, o1;
#pragma unroll
    for (int q = 0; q < 4; ++q) { o0[q] = pg8::cvt4_fp8(s[(4 * q) * 33] * sc, s[(4 * q + 1) * 33] * sc, s[(4 * q + 2) * 33] * sc, s[(4 * q + 3) * 33] * sc);
        o1[q] = pg8::cvt4_fp8(s[(16 + 4 * q) * 33] * sc, s[(16 + 4 * q + 1) * 33] * sc, s[(16 + 4 * q + 2) * 33] * sc, s[(16 + 4 * q + 3) * 33] * sc); }
    unsigned char* dst = WT + (size_t)(drow0 + n) * K + k0 + 32 * hf;
    *(u32x4*)dst = o0; *(u32x4*)(dst + 16) = o1;
    LDS_WAIT(); asm volatile("" ::: "memory");
}
__device__ __forceinline__ void p0_job_f8(const float* W, int K, int N, unsigned char* WT, int mode, int row_off, float sc, int& base, int gw, int NGW, LAS float* scr, int lane) {
    const int nblk = N / 32, nitems = (K / 64) * nblk;
    int it0 = (gw - (base % NGW) + NGW) % NGW;
    for (int it = it0; it < nitems; it += NGW) {
        const int kb = it / nblk, nb = it % nblk, n0 = 32 * nb;
        int drow0;
        if (mode == 0) drow0 = row_off + n0;
        else { const int isu = n0 >= FF, nn = isu ? n0 - FF : n0; drow0 = 256 * (nn / 128) + 128 * isu + (nn % 128); }
        p0_transpose_item_f8(W, K, N, WT, 64 * kb, n0, drow0, sc, scr, lane);
    }
    base += nitems;
}
__device__ __forceinline__ void p0_cvt_rows(const float* X, bf16* XB, size_t n8, size_t gtid, size_t nthreads) {
    for (size_t i = gtid; i < n8; i += nthreads) { const f32x4 a = *(const f32x4*)(X + i * 8), b = *(const f32x4*)(X + i * 8 + 4);
        u32x4 o; o.x = pk2(a[0], a[1]); o.y = pk2(a[2], a[3]); o.z = pk2(b[0], b[1]); o.w = pk2(b[2], b[3]); *(u32x4*)(XB + i * 8) = o; }
}

template <int NR> __device__ __forceinline__ void wave_sum_n(float (&x)[NR]) {
#pragma unroll
    for (int o = 1; o < 64; o <<= 1) {
#pragma unroll
        for (int i = 0; i < NR; ++i) x[i] += __shfl_xor(x[i], o); }
}
template <int NR, bool HPF32, bool ADD2>
__device__ __forceinline__ void ln_rows(const float* Y, const void* HP, const bf16* Y2, const int* tdest, size_t m0, const float* g, const float* b, bf16* OB, float* OF, f32x4 (&v)[NR][4], int lane) {
#pragma unroll
    for (int i = 0; i < NR; ++i) {
        const size_t m = m0 + i;
        const bf16 *a0 = nullptr, *a1 = nullptr;
        if (ADD2) { const int d0 = __builtin_amdgcn_readfirstlane(tdest[2 * m]), d1 = __builtin_amdgcn_readfirstlane(tdest[2 * m + 1]); a0 = Y2 + (size_t)d0 * D; a1 = Y2 + (size_t)d1 * D; }
#pragma unroll
        for (int j = 0; j < 4; ++j) {
            f32x4 h;
            if (HPF32) h = *((const f32x4*)((const float*)HP + m * D) + lane + 64 * j);
            else { const u32x2 w = *((const u32x2*)((const bf16*)HP + m * D) + lane + 64 * j); h = (f32x4){bflo(w.x), bfhi(w.x), bflo(w.y), bfhi(w.y)}; }
            f32x4 y;
            if (ADD2) { const u32x2 w0 = *((const u32x2*)a0 + lane + 64 * j), w1 = *((const u32x2*)a1 + lane + 64 * j);
                y = (f32x4){bflo(w0.x) + bflo(w1.x), bfhi(w0.x) + bfhi(w1.x), bflo(w0.y) + bflo(w1.y), bfhi(w0.y) + bfhi(w1.y)}; }
            else y = *((const f32x4*)(Y + m * D) + lane + 64 * j);
            v[i][j] = h * DN_ALPHA + y;
        }
    }
    float s[NR];
#pragma unroll
    for (int i = 0; i < NR; ++i) { s[i] = 0.f;
#pragma unroll
        for (int j = 0; j < 4; ++j) s[i] += (v[i][j].x + v[i][j].y) + (v[i][j].z + v[i][j].w); }
    wave_sum_n<NR>(s);
    float s2[NR];
#pragma unroll
    for (int i = 0; i < NR; ++i) { const float mean = s[i] * (1.f / D); s2[i] = 0.f;
#pragma unroll
        for (int j = 0; j < 4; ++j) { v[i][j] = v[i][j] - mean; s2[i] += (v[i][j].x * v[i][j].x + v[i][j].y * v[i][j].y) + (v[i][j].z * v[i][j].z + v[i][j].w * v[i][j].w); } }
    wave_sum_n<NR>(s2);
#pragma unroll
    for (int j = 0; j < 4; ++j) { const f32x4 gg = *((const f32x4*)g + lane + 64 * j), bb = *((const f32x4*)b + lane + 64 * j);
#pragma unroll
        for (int i = 0; i < NR; ++i) { const size_t m = m0 + i; const float rstd = 1.f / sqrtf(s2[i] * (1.f / D) + LN_EPS);
            v[i][j] = v[i][j] * rstd * gg + bb;
            if (OB) { u32x2 w; w.x = pk2(v[i][j].x, v[i][j].y); w.y = pk2(v[i][j].z, v[i][j].w); *((u32x2*)(OB + m * D) + lane + 64 * j) = w; }
            if (OF) *((f32x4*)(OF + m * D) + lane + 64 * j) = v[i][j]; } }
}

constexpr float LOG2E_ = 1.4426950408889634f;
__device__ __forceinline__ int scan_row(int tl) { return 32 * (tl >> 5) + att::crow(tl & 15, (tl >> 4) & 1); }
__device__ __forceinline__ void scan_unit(int pass, int b, int n, int c, bool loadW, const bf16* U, const bf16* ZG, bf16* CAT, const bf16* Wg, f32x2* agg,
                                          const float* conv_w, const float* conv_b, const float* b_rg, const float* b_ig, const float* lam, LAS unsigned char* lds) {
    const int tid = threadIdx.x, lane = tid & 63, r32 = lane & 31, hi = lane >> 5; const int wv = __builtin_amdgcn_readfirstlane(tid >> 6);
    LAS unsigned char* At = lds; LAS unsigned char* Wt = lds + 65536;
    LAS f32x2* comp = (LAS f32x2*)(lds + XTRA_OFF);
    LAS float* cin = (LAS float*)(lds + XTRA_OFF + 8192);
    const int t0 = c * 256; const size_t rowbase = (size_t)b * T + t0;
    __syncthreads();
    if (loadW) {
        for (int i = tid; i < 4096; i += 512) { const int row = i >> 4, c16 = i & 15; const u32x4 v = *(const u32x4*)(Wg + ((size_t)n * 256 + row) * 128 + c16 * 8);
            *(LAS u32x4*)(Wt + row * 256 + ((c16 ^ (row & 15)) << 4)) = v; }
    }
    {
        const int ch8 = tid & 15, tg = tid >> 4, chb = n * 128 + ch8 * 8;
        float cw[4][8], cb[8];
#pragma unroll
        for (int j = 0; j < 4; ++j) { const f32x4 a = *(const f32x4*)(conv_w + j * D + chb), bq = *(const f32x4*)(conv_w + j * D + chb + 4);
            cw[j][0] = a[0]; cw[j][1] = a[1]; cw[j][2] = a[2]; cw[j][3] = a[3]; cw[j][4] = bq[0]; cw[j][5] = bq[1]; cw[j][6] = bq[2]; cw[j][7] = bq[3]; }
        { const f32x4 a = *(const f32x4*)(conv_b + chb), bq = *(const f32x4*)(conv_b + chb + 4); cb[0] = a[0]; cb[1] = a[1]; cb[2] = a[2]; cb[3] = a[3]; cb[4] = bq[0]; cb[5] = bq[1]; cb[6] = bq[2]; cb[7] = bq[3]; }
        u32x4 uw[11];
#pragma unroll
        for (int k = 0; k < 11; ++k) { const int tt = tg * 8 - 3 + k; uw[k] = (u32x4){0u, 0u, 0u, 0u};
            if (t0 + tt >= 0) uw[k] = *(const u32x4*)(U + (size_t)((long)rowbase + tt) * D + chb); }
#pragma unroll
        for (int k = 0; k < 8; ++k) { float rr[8];
#pragma unroll
            for (int e = 0; e < 8; ++e) rr[e] = cb[e];
#pragma unroll
            for (int j = 0; j < 4; ++j) { const u32x4 w = uw[k + j];
                rr[0] += cw[j][0] * bflo(w.x); rr[1] += cw[j][1] * bfhi(w.x); rr[2] += cw[j][2] * bflo(w.y); rr[3] += cw[j][3] * bfhi(w.y);
                rr[4] += cw[j][4] * bflo(w.z); rr[5] += cw[j][5] * bfhi(w.z); rr[6] += cw[j][6] * bflo(w.w); rr[7] += cw[j][7] * bfhi(w.w); }
            const int tl = tg * 8 + k, row = scan_row(tl);
            u32x4 w; w.x = pk2(rr[0], rr[1]); w.y = pk2(rr[2], rr[3]); w.z = pk2(rr[4], rr[5]); w.w = pk2(rr[6], rr[7]);
            *(LAS u32x4*)(At + row * 256 + ((ch8 ^ (row & 15)) << 4)) = w; }
    }
    if (pass == 2 && tid < 128) { float H = 0.f; for (int cc = 0; cc < c; ++cc) { const f32x2 ab = agg[((size_t)(b * 16 + cc)) * D + n * 128 + tid]; H = ab.x * H + ab.y; } cin[tid] = H; }
    __syncthreads();
    bf16x8 af[8];
#pragma unroll
    for (int ks = 0; ks < 8; ++ks) { const int row = 32 * wv + r32; af[ks] = *(const LAS bf16x8*)(At + row * 256 + (((2 * ks + hi) ^ (row & 15)) << 4)); }
#pragma unroll 1
    for (int q = 0; q < 4; ++q) {
        f32x16 aR = f32x16{}, aI = f32x16{};
#pragma unroll
        for (int ks = 0; ks < 8; ++ks) { const int brow = 32 * q + r32;
            const bf16x8 bR = *(const LAS bf16x8*)(Wt + brow * 256 + (((2 * ks + hi) ^ (brow & 15)) << 4));
            const bf16x8 bI = *(const LAS bf16x8*)(Wt + (brow + 128) * 256 + (((2 * ks + hi) ^ (brow & 15)) << 4));
            aR = __builtin_amdgcn_mfma_f32_32x32x16_bf16(af[ks], bR, aR, 0, 0, 0);
            aI = __builtin_amdgcn_mfma_f32_32x32x16_bf16(af[ks], bI, aI, 0, 0, 0); }
        const int chl = 32 * q + r32, ch = n * 128 + chl;
        const float br = b_rg[ch], bi = b_ig[ch], cl = -8.0f * log1pf(__expf(-lam[ch]));
        float h = 0.f, cum = 1.f;
#pragma unroll
        for (int r = 0; r < 16; ++r) {
            const int row = 32 * wv + att::crow(r, hi), tl = 32 * wv + 16 * hi + r;
            const float recv = bf2f(*(const LAS unsigned short*)(At + row * 256 + ((((chl >> 3) ^ (row & 15)) << 4)) + (chl & 7) * 2));
            const float rg = sigmoidf_(aR[r] + br), ig = sigmoidf_(aI[r] + bi);
            const float la = cl * rg, a = fast_exp2(LOG2E_ * la); float mult = sqrtf(fmaxf(1.0f - a * a, 0.f));
            if (c == 0 && tl == 0) mult = 1.0f;
            h = a * h + mult * ig * recv; cum *= a; aI[r] = h; aR[r] = cum;
        }
        const float pc = __shfl_xor(cum, 32), ph = __shfl_xor(h, 32);
        const float loc = hi ? pc : cum, loh = hi ? ph : h, hic = hi ? cum : pc, hih = hi ? h : ph;
        LAS f32x2* cq = comp + (q & 1) * 256;
        if (hi == 0) cq[wv * 32 + r32] = (f32x2){loc * hic, hic * loh + hih};
        __syncthreads();
        if (pass == 1) {
            if (tid < 32) { float A = 1.f, B = 0.f;
#pragma unroll
                for (int w = 0; w < 8; ++w) { const f32x2 ab = cq[w * 32 + tid]; B = ab.x * B + ab.y; A = ab.x * A; }
                agg[((size_t)(b * 16 + c)) * D + n * 128 + 32 * q + tid] = (f32x2){A, B}; }
        } else {
            float H = cin[chl];
            for (int w = 0; w < wv; ++w) { const f32x2 ab = cq[w * 32 + r32]; H = ab.x * H + ab.y; }
            if (hi) H = loc * H + loh;
            const bf16* zgb = ZG + rowbase * D + n * 128; bf16* catb = CAT + rowbase * DCAT + n * 128;
            const unsigned tl0 = 32 * wv + 16 * hi;
#pragma unroll
            for (int r = 0; r < 16; ++r) { const unsigned tl = tl0 + r;
                const float hv = aI[r] + aR[r] * H; const float gt = bf2f(zgb[tl * (unsigned)D + (unsigned)chl]);
                catb[tl * (unsigned)DCAT + (unsigned)chl] = (bf16)f2bf(hv * gt); }
        }
    }
}

__global__ void __launch_bounds__(NWAVES * 64, 2) yoco_fwd(Args args) {
    extern __shared__ __attribute__((aligned(16))) unsigned char lds_raw[];
    LAS unsigned char* lds = (LAS unsigned char*)lds_raw;
    const int tid = threadIdx.x, lane = tid & 63; const int wave = __builtin_amdgcn_readfirstlane(tid >> 6);
    const int G = gridDim.x, bx = blockIdx.x;
    const int gw = bx * NWAVES + wave, NGW = G * NWAVES;
    unsigned char* ws = args.ws;
    gu32* ctl = (gu32*)(ws + WS_CTL);
    for (int u = tid; u < (LDS_BYTES - LDSCTL_OFF) / 4; u += NWAVES * 64) ((LAS unsigned*)(lds + LDSCTL_OFF))[u] = 0u;
    __syncthreads();
    XcdBarrier bar = xcd_barrier_post((unsigned*)(ctl + CW_BAR), (volatile LAS unsigned*)(lds + LDSCTL_OFF) + 8);
    const int lo = args.ph_lo, hi_ph = args.ph_hi;
#ifndef PH_MASK
#define PH_MASK 0x1ffff
#endif
#define IN(k) ((((PH_MASK) >> (k)) & 1) && lo <= (k) && (k) < hi_ph)
#define SEAM(k) do { if (IN(k) && IN((k) + 1)) xcd_barrier(bar); } while (0)
#ifndef PROBE_DUP
#define PROBE_DUP (-1)
#endif
#define PH_BEGIN(k) if (IN(k)) for (int rep_ = 0; rep_ < ((PROBE_DUP) == (k) ? 2 : 1); ++rep_) if (rep_ == 0 || (xcd_barrier(bar), true))

    bf16* WZ = (bf16*)(ws + WS_WZ); bf16* WO0 = (bf16*)(ws + WS_WO0); bf16* W13 = (bf16*)(ws + WS_W13); bf16* W2 = (bf16*)(ws + WS_W2); bf16* WMKV = (bf16*)(ws + WS_WMKV);
    bf16* WKVQ = (bf16*)(ws + WS_WKVQ); bf16* WO1 = (bf16*)(ws + WS_WO1); bf16* WG = (bf16*)(ws + WS_WG); bf16* WM13 = (bf16*)(ws + WS_WM13); bf16* WM2 = (bf16*)(ws + WS_WM2);
    bf16* XB = (bf16*)(ws + WS_XB); bf16* MEMB = (bf16*)(ws + WS_MEMB); bf16* ZG = (bf16*)(ws + WS_ZG); bf16* U = (bf16*)(ws + WS_U); bf16* QM0 = (bf16*)(ws + WS_QM0);
    bf16* MKV = (bf16*)(ws + WS_MKV); f32x2* AGG = (f32x2*)(ws + WS_AGG); bf16* CAT = (bf16*)(ws + WS_CAT); float* Y = (float*)(ws + WS_Y);
    bf16* H1 = (bf16*)(ws + WS_H1); bf16* H2 = (bf16*)(ws + WS_H2); bf16* H3 = (bf16*)(ws + WS_H3); bf16* HID = (bf16*)(ws + WS_HID);
    bf16* KB = (bf16*)(ws + WS_K); bf16* VB = (bf16*)(ws + WS_V); bf16* QD = (bf16*)(ws + WS_QD); bf16* QM1 = (bf16*)(ws + WS_QM1); float* STASH = (float*)(ws + WS_STASH);
    bf16* AG = (bf16*)(ws + WS_AG); bf16* HIDM = (bf16*)(ws + WS_HIDM); bf16* Y2 = (bf16*)(ws + WS_Y2);
    int* RTE = (int*)(ws + RT_E); float* RTG = (float*)(ws + RT_G); int* WCNT = (int*)(ws + RT_WCNT); int* STOK = (int*)(ws + RT_STOK); float* SGATE = (float*)(ws + RT_SGATE);
    int* TDEST = (int*)(ws + RT_TDEST); int* TILEE = (int*)(ws + RT_TILEE); int* META = (int*)(ws + RT_META);
    const float* ln_g = args.in[IN_LN_G]; const float* ln_b = args.in[IN_LN_B];

    PH_BEGIN(0) {
        LAS float* scr = (LAS float*)(lds + RING_OFF + wave * 16384);
        int base = 0;
        p0_job(args.in[IN_A_W_IN], D, DZ, WZ, 0, 0, base, gw, NGW, scr, lane);
        p0_job(args.in[IN_A_W_OUT], DCAT, D, WO0, 0, 0, base, gw, NGW, scr, lane);
        p0_job(args.in[IN_FFN_W13], D, 2 * FF, W13, 1, 0, base, gw, NGW, scr, lane);
        p0_job(args.in[IN_FFN_W2], FF, D, W2, 0, 0, base, gw, NGW, scr, lane);
        p0_job(args.in[IN_MEM_W_KV], D, D, WMKV, 0, 0, base, gw, NGW, scr, lane);
        p0_job(args.in[IN_MEM_W_KV] + (size_t)D * D, D, D, WMKV, 0, D, base, gw, NGW, scr, lane);
        p0_job(args.in[IN_W_KV], D, 2 * D, WKVQ, 0, 0, base, gw, NGW, scr, lane);
        p0_job(args.in[IN_B_W_Q], D, DCAT, WKVQ, 0, 2 * D, base, gw, NGW, scr, lane);
        p0_job(args.in[IN_B_W_OUT], DCAT, D, WO1, 0, 0, base, gw, NGW, scr, lane);
        for (int n = 0; n < 8; ++n) {
            p0_job(args.in[IN_A_W_RG] + (size_t)n * 16384, 128, 128, WG, 0, n * 256, base, gw, NGW, scr, lane);
            p0_job(args.in[IN_A_W_IG] + (size_t)n * 16384, 128, 128, WG, 0, n * 256 + 128, base, gw, NGW, scr, lane);
        }
        for (int e = 0; e < NEXP; ++e) {
            p0_job_f8(args.in[IN_MOE_W13] + (size_t)e * D * 2 * FF, D, 2 * FF, (unsigned char*)WM13 + (size_t)e * 2 * FF * D, 1, 0, WSC13, base, gw, NGW, scr, lane);
            p0_job_f8(args.in[IN_MOE_W2] + (size_t)e * FF * D, FF, D, (unsigned char*)WM2 + (size_t)e * D * FF, 0, 0, WSC2, base, gw, NGW, scr, lane);
        }
        const size_t gtid = (size_t)bx * 512 + tid, nth = (size_t)G * 512;
        p0_cvt_rows(args.in[IN_X], XB, (size_t)M * D / 8, gtid, nth);
        p0_cvt_rows(args.in[IN_MEM], MEMB, (size_t)MEMROWS * D / 8, gtid, nth);
    }
    SEAM(0);

    PH_BEGIN(1) {
        { pg8::Gemm g{XB, WZ, M, DZ, D, 0}; pg8::StaticOrder S; S.init(M, DZ, G, bx);
          pg8::EpiSegT<0> E{ws};
          pg8::gemm_phase<pg8::EpiSegT<0>, pg8::StaticOrder, true, true>(lds + RING_OFF, g, S, E); }
        { pg8::Gemm g{MEMB, WMKV, MEMROWS, 2 * D, D, 0}; pg8::StaticOrder S; S.init(MEMROWS, 2 * D, G, bx);
          pg8::EpiSegT<1> E{ws};
          pg8::gemm_phase<pg8::EpiSegT<1>, pg8::StaticOrder, true, true>(lds + RING_OFF, g, S, E); }
    }
    SEAM(1);

    PH_BEGIN(2) {
        bool first = true;
        for (int L = bx; L < 1024; L += G) { const int pair = L & 63, c = L >> 6; scan_unit(1, pair >> 3, pair & 7, c, first || (G & 63), U, ZG, CAT, WG, AGG,
                args.in[IN_A_CONV_W], args.in[IN_A_CONV_B], args.in[IN_A_B_RG], args.in[IN_A_B_IG], args.in[IN_A_LAMBDA], lds); first = false; }
        __syncthreads();
        for (int L = bx; L < 512; L += G) { const int b = L >> 6, hd = (L >> 4) & 3, qb = L & 15; const size_t row0 = (size_t)b * T + qb * 256 + wave * 32;
            f32x16 o[4];
            att::attn_core<128, 128, false>(QM0 + row0 * 512 + hd * 128, 512, MKV + (size_t)b * MEMT * 2 * D + hd * 128, 2 * D, MKV + (size_t)b * MEMT * 2 * D + 512 + hd * 128, 2 * D, 4, 0, 0, 0.f, lds, o);
            att::store_o128(o, CAT + row0 * DCAT + D + hd * 128, DCAT, lds); }
    }
    SEAM(2);

    PH_BEGIN(3) {
        bool first = true;
        for (int L = bx; L < 1024; L += G) { const int pair = L & 63, c = L >> 6; scan_unit(2, pair >> 3, pair & 7, c, first || (G & 63), U, ZG, CAT, WG, AGG,
                args.in[IN_A_CONV_W], args.in[IN_A_CONV_B], args.in[IN_A_B_RG], args.in[IN_A_B_IG], args.in[IN_A_LAMBDA], lds); first = false; }
        __syncthreads();
    }
    SEAM(3);

    PH_BEGIN(4) { pg8::Gemm g{CAT, WO0, M, D, DCAT, 0}; pg8::StaticOrder S; S.init(M, D, G, bx); pg8::EpiF32 E{Y, D};
        pg8::gemm_phase<pg8::EpiF32, pg8::StaticOrder, true, true>(lds + RING_OFF, g, S, E); }
    SEAM(4);
    PH_BEGIN(5) { for (int m0 = gw * 4; m0 < M; m0 += NGW * 4) { f32x4 v[4][4]; ln_rows<4, true, false>(Y, args.in[IN_X], nullptr, nullptr, (size_t)m0, ln_g, ln_b, H1, nullptr, v, lane); } }
    SEAM(5);
    PH_BEGIN(6) { pg8::Gemm g{H1, W13, M, 2 * FF, D, 0}; pg8::StaticOrder S; S.init(M, 2 * FF, G, bx); pg8::EpiSwiGLU E{HID, FF};
        pg8::gemm_phase<pg8::EpiSwiGLU, pg8::StaticOrder, true, true>(lds + RING_OFF, g, S, E); }
    SEAM(6);
    PH_BEGIN(7) { pg8::Gemm g{HID, W2, M, D, FF, 0}; pg8::StaticOrder S; S.init(M, D, G, bx); pg8::EpiF32 E{Y, D};
        pg8::gemm_phase<pg8::EpiF32, pg8::StaticOrder, true, true>(lds + RING_OFF, g, S, E); }
    SEAM(7);
    PH_BEGIN(8) { for (int m0 = gw * 4; m0 < M; m0 += NGW * 4) { f32x4 v[4][4]; ln_rows<4, false, false>(Y, H1, nullptr, nullptr, (size_t)m0, ln_g + D, ln_b + D, H2, nullptr, v, lane); } }
    SEAM(8);
    PH_BEGIN(9) { pg8::Gemm g{H2, WKVQ, M, NKVQ, D, 0}; pg8::StaticOrder S; S.init(M, NKVQ, G, bx);
        pg8::EpiSegT<2> E{ws};
        pg8::gemm_phase<pg8::EpiSegT<2>, pg8::StaticOrder, true, true>(lds + RING_OFF, g, S, E); }
    SEAM(9);
    PH_BEGIN(10) {
        const float* lv = args.in[IN_B_LAMBDA];
        const float s1 = wave_sum(lv[lane] * lv[64 + lane]), s2 = wave_sum(lv[128 + lane] * lv[192 + lane]);
        const float lam = __expf(s1) - __expf(s2) + LAM_INIT;
        const int r32 = lane & 31, hi = lane >> 5;
        for (int L = bx; L < 1024; L += G) {
            const int i = L >> 8, w = L & 255, pair = w & 63, j = w >> 6, b = pair >> 3, h = pair & 7;
            const int qb = (i == 0) ? j : (i == 1) ? 7 - j : (i == 2) ? 8 + j : 15 - j;
            const size_t rowb = (size_t)b * T, row0 = rowb + qb * 256 + wave * 32;
            const float slope2 = exp2f(-(float)(h + 1)) * LOG2E;
            const int NT = (qb * 256 + 256) / 64, qpos0 = qb * 256 + wave * 32, qref = qb * 256 + 255;
            f32x4* st = (f32x4*)(STASH + (size_t)(bx * NWAVES + wave) * 4096) + lane * 16;
            f32x16 o[4];
#ifndef T10_NOFIRST
            att::attn_core<64, 128, true>(QD + row0 * D + h * 128 + 64, D, KB + rowb * D + h * 128 + 64, D, VB + rowb * D + h * 128, D, NT, qpos0, qref, slope2, lds, o);
#pragma unroll
            for (int d = 0; d < 4; ++d)
#pragma unroll
                for (int r4 = 0; r4 < 4; ++r4) st[d * 4 + r4] = (f32x4){o[d][4 * r4], o[d][4 * r4 + 1], o[d][4 * r4 + 2], o[d][4 * r4 + 3]};
#endif
            att::attn_core<64, 128, true>(QD + row0 * D + h * 128, D, KB + rowb * D + h * 128, D, VB + rowb * D + h * 128, D, NT, qpos0, qref, slope2, lds, o);
            VM_WAIT();
#ifndef T10_NOCOMB
            float gsub[4];
#pragma unroll
            for (int d = 0; d < 4; ++d) gsub[d] = args.in[IN_B_SUBLN][32 * d + r32] * (1.0f - LAM_INIT);
#pragma unroll
            for (int r4 = 0; r4 < 4; ++r4) {
                f32x4 s1[4];
#pragma unroll
                for (int d = 0; d < 4; ++d) s1[d] = st[d * 4 + r4];
#pragma unroll
                for (int k = 0; k < 4; ++k) { const int r = 4 * r4 + k; float ss = 0.f;
#pragma unroll
                    for (int d = 0; d < 4; ++d) { const float x = o[d][r] - lam * s1[d][k]; o[d][r] = x; ss += x * x; }
                    ss += __shfl_xor(ss, 1); ss += __shfl_xor(ss, 2); ss += __shfl_xor(ss, 4); ss += __shfl_xor(ss, 8); ss += __shfl_xor(ss, 16);
                    const float rinv = 1.0f / sqrtf(ss * (1.0f / 128.0f) + LN_EPS);
#pragma unroll
                    for (int d = 0; d < 4; ++d) o[d][r] *= rinv * gsub[d]; }
            }
#endif
            att::store_o128(o, CAT + row0 * DCAT + h * 128, DCAT, lds);
        }
        for (int L = bx; L < 512; L += G) { const int b = L >> 6, hd = (L >> 4) & 3, qb = L & 15; const size_t row0 = (size_t)b * T + qb * 256 + wave * 32;
            f32x16 o[4];
            att::attn_core<128, 128, false>(QM1 + row0 * 512 + hd * 128, 512, MKV + (size_t)b * MEMT * 2 * D + D + hd * 128, 2 * D, MKV + (size_t)b * MEMT * 2 * D + D + 512 + hd * 128, 2 * D, 4, 0, 0, 0.f, lds, o);
            att::store_o128(o, CAT + row0 * DCAT + D + hd * 128, DCAT, lds); }
        __syncthreads();
    }
    SEAM(10);
    PH_BEGIN(11) { pg8::Gemm g{CAT, WO1, M, D, DCAT, 0}; pg8::StaticOrder S; S.init(M, D, G, bx); pg8::EpiF32 E{Y, D};
        pg8::gemm_phase<pg8::EpiF32, pg8::StaticOrder, true, true>(lds + RING_OFF, g, S, E); }
    SEAM(11);
    PH_BEGIN(12) {
        LAS float* wr = (LAS float*)lds;
        for (int i = tid; i < D * NEXP / 4; i += 512) ((LAS f32x4*)wr)[i] = ((const f32x4*)args.in[IN_MOE_ROUTER])[i];
        __syncthreads();
        for (int slot = gw; slot < NSLOT; slot += NGW) {
            unsigned long long cnt64 = 0ull;
            for (int i4 = 0; i4 < 16; i4 += 4) { const int m0 = slot * 16 + i4; f32x4 v[4][4];
                ln_rows<4, false, false>(Y, H2, nullptr, nullptr, (size_t)m0, ln_g + 2 * D, ln_b + 2 * D, H3, nullptr, v, lane);
                float lg[4][8];
#pragma unroll
                for (int i = 0; i < 4; ++i)
#pragma unroll
                    for (int e = 0; e < 8; ++e) lg[i][e] = 0.f;
#pragma unroll
                for (int j = 0; j < 4; ++j)
#pragma unroll
                    for (int k = 0; k < 4; ++k) { const int col = 4 * lane + 256 * j + k; const f32x4 w0 = *(const LAS f32x4*)(wr + col * 8), w1 = *(const LAS f32x4*)(wr + col * 8 + 4);
#pragma unroll
                        for (int i = 0; i < 4; ++i) { const float x = v[i][j][k];
                            lg[i][0] += x * w0[0]; lg[i][1] += x * w0[1]; lg[i][2] += x * w0[2]; lg[i][3] += x * w0[3]; lg[i][4] += x * w1[0]; lg[i][5] += x * w1[1]; lg[i][6] += x * w1[2]; lg[i][7] += x * w1[3]; }
                        if (k == 3) __builtin_amdgcn_sched_barrier(0); }
#pragma unroll
                for (int o = 1; o < 64; o <<= 1)
#pragma unroll
                    for (int i = 0; i < 4; ++i)
#pragma unroll
                        for (int e = 0; e < 8; ++e) lg[i][e] += __shfl_xor(lg[i][e], o);
#pragma unroll
                for (int i = 0; i < 4; ++i) { const int m = m0 + i;
                    int e0 = 0; float v0 = lg[i][0];
#pragma unroll
                    for (int e = 1; e < 8; ++e) if (lg[i][e] > v0) { v0 = lg[i][e]; e0 = e; }
                    int e1 = -1; float v1 = -INFINITY;
#pragma unroll
                    for (int e = 0; e < 8; ++e) if (e != e0 && lg[i][e] > v1) { v1 = lg[i][e]; e1 = e; }
                    e0 = __builtin_amdgcn_readfirstlane(e0); e1 = __builtin_amdgcn_readfirstlane(e1);
                    const float g0 = 1.0f / (1.0f + __expf(v1 - v0));
                    if (lane == 0) { RTE[m] = e0 | (e1 << 8); RTG[2 * m] = g0; RTG[2 * m + 1] = 1.0f - g0; }
                    cnt64 += (1ull << (8 * e0)) + (1ull << (8 * e1)); }
            }
            if (lane < 8) WCNT[slot * 8 + lane] = (int)((cnt64 >> (8 * lane)) & 0xffull);
        }
        __syncthreads();
    }
    SEAM(12);
    PH_BEGIN(13) {
        LAS int* cnt = (LAS int*)lds; LAS int* part = cnt + NSLOT * 8; LAS int* meta = part + 512;
        for (int i = tid; i < NSLOT * 8; i += 512) cnt[i] = WCNT[i];
        __syncthreads();
        { const int e = tid & 7, j = tid >> 3; int s = 0; for (int k = 0; k < 32; ++k) s += cnt[(32 * j + k) * 8 + e]; part[j * 8 + e] = s; }
        __syncthreads();
        if (tid < 8) { int run = 0; for (int j = 0; j < 64; ++j) { const int t = part[j * 8 + tid]; part[j * 8 + tid] = run; run += t; } meta[tid] = run; }
        __syncthreads();
        if (tid == 0) { int ps = 0; for (int e = 0; e < 8; ++e) { meta[8 + e] = ps; ps += (meta[e] + 255) / 256 * 256; } meta[16] = ps / 256; }
        { const int e = tid & 7, j = tid >> 3; int run = part[j * 8 + e]; for (int k = 0; k < 32; ++k) { const int t = cnt[(32 * j + k) * 8 + e]; cnt[(32 * j + k) * 8 + e] = run; run += t; } }
        __syncthreads();
        if (bx == 0) { const int nt = meta[16]; if (tid == 0) META[0] = nt;
            for (int pm = tid; pm < 512; pm += 512) { int e = 7; for (int q = 7; q >= 0; --q) if (pm * 256 < meta[8 + q] + (meta[q] + 255) / 256 * 256) e = q; TILEE[pm] = (pm < nt) ? e : 0; } }
        for (int slot = gw; slot < NSLOT; slot += NGW) {
            unsigned long long lc = 0ull;
            for (int i = 0; i < 16; ++i) { const int m = slot * 16 + i; const int ee = __builtin_amdgcn_readfirstlane(RTE[m]);
#pragma unroll
                for (int k = 0; k < 2; ++k) { const int e = (ee >> (8 * k)) & 0xff; const int dest = meta[8 + e] + cnt[slot * 8 + e] + (int)((lc >> (8 * e)) & 0xffull); lc += 1ull << (8 * e);
                    if (lane == 0) { STOK[dest] = m; SGATE[dest] = RTG[2 * m + k]; TDEST[2 * m + k] = dest; }
                    const u32x4 a = *((const u32x4*)(H3 + (size_t)m * D) + 2 * lane), c2 = *((const u32x4*)(H3 + (size_t)m * D) + 2 * lane + 1);
                    u32x4 o8; o8.x = pg8::cvt4_fp8(bflo(a.x), bfhi(a.x), bflo(a.y), bfhi(a.y)); o8.y = pg8::cvt4_fp8(bflo(a.z), bfhi(a.z), bflo(a.w), bfhi(a.w));
                    o8.z = pg8::cvt4_fp8(bflo(c2.x), bfhi(c2.x), bflo(c2.y), bfhi(c2.y)); o8.w = pg8::cvt4_fp8(bflo(c2.z), bfhi(c2.z), bflo(c2.w), bfhi(c2.w));
                    *((u32x4*)((unsigned char*)AG + (size_t)dest * D) + lane) = o8; }
            }
        }
        __syncthreads();
    }
    SEAM(13);
    PH_BEGIN(14) { const int nt = __builtin_amdgcn_readfirstlane(META[0]);
        pg8::Gemm g{AG, WM13, nt * 256, 2 * FF, D / 2, (size_t)2 * FF * D}; pg8::GroupedOrder S; S.init(nt * 256, 2 * FF, G, bx); S.tile_e = TILEE; pg8::EpiSwiGLU8 E{(unsigned char*)HIDM, FF, 1.0f / WSC13, HSC};
        pg8::gemm_phase<pg8::EpiSwiGLU8, pg8::GroupedOrder, true, true, true>(lds + RING_OFF, g, S, E); }
    SEAM(14);
    PH_BEGIN(15) { const int nt = __builtin_amdgcn_readfirstlane(META[0]);
        pg8::Gemm g{HIDM, WM2, nt * 256, D, FF / 2, (size_t)D * FF}; pg8::GroupedOrder S; S.init(nt * 256, D, G, bx); S.tile_e = TILEE; pg8::EpiRowScale E{Y2, D, SGATE, 1.0f / (WSC2 * HSC)};
        pg8::gemm_phase<pg8::EpiRowScale, pg8::GroupedOrder, true, true, true>(lds + RING_OFF, g, S, E); }
    SEAM(15);
    PH_BEGIN(16) { for (int m0 = gw * 4; m0 < M; m0 += NGW * 4) { f32x4 v[4][4]; ln_rows<4, false, true>(nullptr, H3, Y2, TDEST, (size_t)m0, ln_g + 3 * D, ln_b + 3 * D, nullptr, args.out, v, lane); } }
#undef IN
#undef SEAM
}

#ifndef MK_ONE_LAUNCH
#define MK_ONE_LAUNCH 1
#endif
extern "C" void kernel_launch(void* const* d_in, const int* in_sizes, int n_in, void* d_out, int out_size, void* d_ws, size_t ws_size, hipStream_t stream) {
    static int grid = 0;
    if (grid == 0) {
        if (n_in != N_IN || in_sizes[0] != M * D || out_size != M * D || ws_size < WS_END) { fprintf(stderr, "kernel_launch: unexpected shapes (n_in %d, in0 %d, out %d, ws %zu < %zu)\n", n_in, n_in > 0 ? in_sizes[0] : -1, out_size, ws_size, (size_t)WS_END); grid = -1; return; }
        int dev = 0, cus = 0, per_cu = 0;
        if (hipGetDevice(&dev) != hipSuccess || hipDeviceGetAttribute(&cus, hipDeviceAttributeMultiprocessorCount, dev) != hipSuccess) { grid = -1; return; }
        if (hipFuncSetAttribute((const void*)yoco_fwd, hipFuncAttributeMaxDynamicSharedMemorySize, LDS_BYTES) != hipSuccess) { fprintf(stderr, "kernel_launch: hipFuncSetAttribute failed\n"); grid = -1; return; }
        if (hipOccupancyMaxActiveBlocksPerMultiprocessor(&per_cu, (const void*)yoco_fwd, NWAVES * 64, LDS_BYTES) != hipSuccess || per_cu < 1) fprintf(stderr, "kernel_launch: occupancy query says %d\n", per_cu);
        (void)hipGetLastError();
        grid = cus;
    }
    if (grid < 0) return;
    (void)hipMemsetAsync((char*)d_ws + WS_CTL, 0, CTL_ZERO_BYTES, stream);
    Args a{};
    for (int i = 0; i < N_IN; ++i) a.in[i] = (const float*)d_in[i];
    a.out = (float*)d_out; a.ws = (unsigned char*)d_ws;
#if MK_ONE_LAUNCH
    a.ph_lo = 0; a.ph_hi = N_PHASES;
    hipLaunchKernelGGL(yoco_fwd, dim3(grid), dim3(NWAVES * 64), LDS_BYTES, stream, a);
#else
    for (int p = 0; p < N_PHASES; ++p) { a.ph_lo = p; a.ph_hi = p + 1; hipLaunchKernelGGL(yoco_fwd, dim3(grid), dim3(NWAVES * 64), LDS_BYTES, stream, a); }
#endif
    const hipError_t le = hipPeekAtLastError();
    if (le != hipSuccess) fprintf(stderr, "kernel_launch: launch failed: %s\n", hipGetErrorName(le));
}
```

```cpp
#include <hip/hip_runtime.h>
#include <cstdio>
#include <cstdint>

#define LAS __attribute__((address_space(3)))
#define GAS __attribute__((address_space(1)))
typedef unsigned short bf16;
typedef short bf16x8 __attribute__((ext_vector_type(8)));
typedef short s16x4 __attribute__((ext_vector_type(4)));
typedef float f32x2 __attribute__((ext_vector_type(2)));
typedef float f32x4 __attribute__((ext_vector_type(4)));
typedef float f32x16 __attribute__((ext_vector_type(16)));
typedef unsigned u32x2 __attribute__((ext_vector_type(2)));
typedef unsigned u32x4 __attribute__((ext_vector_type(4)));

__device__ __forceinline__ unsigned cvt_pk_bf16(float lo, float hi) { unsigned r; asm volatile("v_cvt_pk_bf16_f32 %0, %1, %2" : "=v"(r) : "v"(lo), "v"(hi)); return r; }
__device__ __forceinline__ float bf2f(unsigned short b) { return __uint_as_float(((unsigned)b) << 16); }
__device__ __forceinline__ float bflo(unsigned w) { return __uint_as_float(w << 16); }
__device__ __forceinline__ float bfhi(unsigned w) { return __uint_as_float(w & 0xffff0000u); }
__device__ __forceinline__ float fast_exp2(float x) { return __builtin_amdgcn_exp2f(x); }
__device__ __forceinline__ float fast_rcp(float x) { return __builtin_amdgcn_rcpf(x); }
__device__ __forceinline__ float sigmoidf_(float x) { return fast_rcp(1.0f + fast_exp2(-1.4426950408889634f * x)); }

namespace pg8 {
#define PG8_LAS __attribute__((address_space(3)))
typedef unsigned short bf16_t;
constexpr int BM = 256, BK = 64, HALF = 128, HTB = HALF * BK * 2  , STAGE_BYTES = 8 * HTB, NXCD = 8, WGM = 8;

__host__ __device__ __forceinline__ int lds_byte(int r, int c) { const int st = (r >> 4) * 2 + (c >> 5), rr = r & 15, cc = c & 31, ob = rr * 64 + cc * 2; return st * 1024 + (ob ^ (((ob >> 9) & 1) << 5)); }
__host__ __device__ __forceinline__ void stage_rc(int b, int& R, int& C) { const int st = b / 1024, sb = b % 1024, swz = sb ^ (((sb >> 9) & 1) << 5); R = (st >> 1) * 16 + swz / 64; C = (st & 1) * 32 + (swz % 64) / 2; }
__host__ __device__ __forceinline__ int perm32(int rho) { const int n = rho >> 4, i = rho & 15; return 8 * (i >> 2) + 4 * n + (i & 3); }

typedef int v8i_t __attribute__((ext_vector_type(8))); typedef int v4i_t __attribute__((ext_vector_type(4)));
__device__ __forceinline__ v8i_t pg8_cat(bf16x8 a, bf16x8 b) { const v4i_t x = __builtin_bit_cast(v4i_t, a), y = __builtin_bit_cast(v4i_t, b); return __builtin_shufflevector(x, y, 0, 1, 2, 3, 4, 5, 6, 7); }
struct Unit { int pm, pn, e; };
struct Gemm { const bf16_t* A; const bf16_t* Bt; int M, N, K; size_t estride; };

struct StaticOrder {
    int nM, nN, nwg, G, c;
    __host__ __device__ void init(int M, int N, int G_, int c_) { nM = M / BM; nN = N / BM; nwg = nM * nN; G = G_; c = c_; }
    __host__ __device__ bool next(int i, Unit& u) const {
        const long L = (long)i * G + c; if (L >= nwg) return false;
        int wgid = (int)L; { const int q = nwg / NXCD, r = nwg % NXCD, xcd = wgid % NXCD, off = wgid / NXCD; wgid = (xcd < r ? xcd * (q + 1) : r * (q + 1) + (xcd - r) * q) + off; }
        const int nig = WGM * nN, gid = wgid / nig, fm = gid * WGM, gsz = (nM - fm) < WGM ? (nM - fm) : WGM;
        u.pm = fm + ((wgid % nig) % gsz); u.pn = (wgid % nig) / gsz; u.e = 0; return true;
    }
    __device__ __forceinline__ void a_ready(const Unit&) const {}
    __device__ __forceinline__ void done(const Unit&) const {}
};
struct GroupedOrder : StaticOrder {
    const int* tile_e;
    __device__ bool next(int i, Unit& u) const { if (!StaticOrder::next(i, u)) return false; u.e = __builtin_amdgcn_readfirstlane(tile_e[u.pm]); return true; }
};

struct EpiF32 {
    static constexpr bool PERM = false, AFTER_DRAIN = false;
    float* C; int ldc; float cs;
    __device__ __forceinline__ void operator()(const f32x4 (&acc)[2][2][4][2], const Unit& u, int wr, int wc, int fr, int fq) const {
        const int row0 = u.pm * BM + wr * 64 + fr, col0 = u.pn * BM + wc * 32 + 4 * fq;
#pragma unroll
        for (int ai = 0; ai < 2; ++ai)
#pragma unroll
            for (int m = 0; m < 4; ++m) { float* rowp = C + (size_t)(row0 + ai * HALF + m * 16) * ldc + col0;
#pragma unroll
                for (int bj = 0; bj < 2; ++bj)
#pragma unroll
                    for (int n = 0; n < 2; ++n) *(f32x4*)(rowp + bj * HALF + n * 16) = acc[ai][bj][m][n] * cs; }
    }
};
__device__ __forceinline__ float gelu_tanh(float x) { const float y = x * (1.0f + 0.044715f * x * x); return x * fast_rcp(1.0f + fast_exp2(-2.302208198f * y)); }
struct EpiSwiGLU {
    static constexpr bool PERM = true, AFTER_DRAIN = false;
    bf16_t* H; int ldh;
    __device__ __forceinline__ void operator()(const f32x4 (&acc)[2][2][4][2], const Unit& u, int wr, int wc, int fr, int fq) const {
        const int row0 = u.pm * BM + wr * 64 + fr, col0 = u.pn * HALF + wc * 32 + 8 * fq;
#pragma unroll
        for (int ai = 0; ai < 2; ++ai)
#pragma unroll
            for (int m = 0; m < 4; ++m) { bf16_t* rowp = H + (size_t)(row0 + ai * HALF + m * 16) * ldh + col0;
                f32x4 h0, h1;
#pragma unroll
                for (int j = 0; j < 4; ++j) { const float g0 = acc[ai][0][m][0][j], g1 = acc[ai][0][m][1][j];
                    h0[j] = g0 * fast_rcp(1.0f + fast_exp2(-1.4426950408889634f * g0)) * acc[ai][1][m][0][j];
                    h1[j] = g1 * fast_rcp(1.0f + fast_exp2(-1.4426950408889634f * g1)) * acc[ai][1][m][1][j]; }
                u32x4 w; w.x = cvt_pk_bf16(h0[0], h0[1]); w.y = cvt_pk_bf16(h0[2], h0[3]); w.z = cvt_pk_bf16(h1[0], h1[1]); w.w = cvt_pk_bf16(h1[2], h1[3]);
                *(u32x4*)rowp = w; }
    }
};
struct EpiRowScale {
    static constexpr bool PERM = true, AFTER_DRAIN = false;
    bf16_t* O; int ldc; const float* rs; float cs;
    __device__ __forceinline__ void operator()(const f32x4 (&acc)[2][2][4][2], const Unit& u, int wr, int wc, int fr, int fq) const {
        const int row0 = u.pm * BM + wr * 64 + fr, col0 = u.pn * BM + wc * 32 + 8 * fq;
#pragma unroll
        for (int ai = 0; ai < 2; ++ai)
#pragma unroll
            for (int m = 0; m < 4; ++m) { const int row = row0 + ai * HALF + m * 16; const float g = rs[row] * cs; bf16_t* rowp = O + (size_t)row * ldc + col0;
#pragma unroll
                for (int bj = 0; bj < 2; ++bj) { const f32x4 v0 = acc[ai][bj][m][0] * g, v1 = acc[ai][bj][m][1] * g;
                    u32x4 w; w.x = cvt_pk_bf16(v0[0], v0[1]); w.y = cvt_pk_bf16(v0[2], v0[3]); w.z = cvt_pk_bf16(v1[0], v1[1]); w.w = cvt_pk_bf16(v1[2], v1[3]);
                    *(u32x4*)(rowp + bj * HALF) = w; } }
    }
};


__device__ __forceinline__ unsigned cvt4_fp8(float a, float b, float c, float d) {
    a = fminf(fmaxf(a, -448.f), 448.f); b = fminf(fmaxf(b, -448.f), 448.f); c = fminf(fmaxf(c, -448.f), 448.f); d = fminf(fmaxf(d, -448.f), 448.f);
    int w = 0; w = __builtin_amdgcn_cvt_pk_fp8_f32(a, b, w, false); w = __builtin_amdgcn_cvt_pk_fp8_f32(c, d, w, true); return (unsigned)w; }
struct EpiSwiGLU8 {
    static constexpr bool PERM = true, AFTER_DRAIN = false;
    unsigned char* H; int ldh; float ws, hs;
    __device__ __forceinline__ void operator()(const f32x4 (&acc)[2][2][4][2], const Unit& u, int wr, int wc, int fr, int fq) const {
        const int row0 = u.pm * BM + wr * 64 + fr, col0 = u.pn * HALF + wc * 32 + 8 * fq;
#pragma unroll
        for (int ai = 0; ai < 2; ++ai)
#pragma unroll
            for (int m = 0; m < 4; ++m) { unsigned char* rowp = H + (size_t)(row0 + ai * HALF + m * 16) * ldh + col0;
                f32x4 h0, h1;
#pragma unroll
                for (int j = 0; j < 4; ++j) { const float g0 = acc[ai][0][m][0][j] * ws, g1 = acc[ai][0][m][1][j] * ws;
                    h0[j] = g0 * fast_rcp(1.0f + fast_exp2(-1.4426950408889634f * g0)) * (acc[ai][1][m][0][j] * (ws * hs));
                    h1[j] = g1 * fast_rcp(1.0f + fast_exp2(-1.4426950408889634f * g1)) * (acc[ai][1][m][1][j] * (ws * hs)); }
                u32x2 w; w.x = cvt4_fp8(h0[0], h0[1], h0[2], h0[3]); w.y = cvt4_fp8(h1[0], h1[1], h1[2], h1[3]);
                *(u32x2*)rowp = w; }
    }
};
template <class Epi, class Sched, bool ALIGN_EPI = false, bool SP2 = false, bool F8 = false>
__device__ __forceinline__ void gemm_phase(PG8_LAS unsigned char* lds, const Gemm g, const Sched& S, const Epi& E) {
    const int tid = threadIdx.x, wid = __builtin_amdgcn_readfirstlane(tid >> 6), lane = tid & 63, wr = wid >> 2, wc = wid & 3, fr = lane & 15, fq = lane >> 4;
    const int K = g.K, nt = K / BK;
    unsigned voffA[2], voffB[2];
#pragma unroll
    for (int i = 0; i < 2; ++i) { int R, C; stage_rc(tid * 16 + i * 8192, R, C); const int Rb = Epi::PERM ? ((R & ~31) + perm32(R & 31)) : R;
        voffA[i] = (unsigned)(R * K + C) * 2u; voffB[i] = (unsigned)(Rb * K + C) * 2u; }
    const size_t kstep = (size_t)(BK * 2);
    const size_t hstep = (size_t)HALF * K * 2;
    const size_t tstep = 2 * hstep;
    const unsigned ldsw = (unsigned)wid * 1024u;
    const int aoff = lds_byte(wr * 64 + fr, fq * 8), boff = lds_byte(wc * 32 + fr, fq * 8);
#define PG8_SA(b, h) (((b) * 2 + (h)) * HTB)
#define PG8_SB(b, h) ((4 + (b) * 2 + (h)) * HTB)
#define PG8_STAGE(bufoff, gbase, voff) do { _Pragma("unroll") for (int _i = 0; _i < 2; ++_i) \
        __builtin_amdgcn_global_load_lds((const unsigned*)((const char*)(gbase) + (voff)[_i]), (PG8_LAS unsigned*)(lds + (bufoff) + ldsw + _i * 8192), 16, 0, 0); } while (0)
#define PG8_LDA(dst, b, h) do { _Pragma("unroll") for (int m = 0; m < 4; ++m) { const bf16x8 x0_ = *(const PG8_LAS bf16x8*)(lds + PG8_SA(b, h) + aoff + m * 2048), x1_ = *(const PG8_LAS bf16x8*)(lds + PG8_SA(b, h) + aoff + m * 2048 + 1024); \
        if constexpr (F8) dst##8[m] = pg8_cat(x0_, x1_); else { dst[m][0] = x0_; dst[m][1] = x1_; } } } while (0)
#define PG8_LDB(dst, b, h) do { _Pragma("unroll") for (int n = 0; n < 2; ++n) { const bf16x8 x0_ = *(const PG8_LAS bf16x8*)(lds + PG8_SB(b, h) + boff + n * 2048), x1_ = *(const PG8_LAS bf16x8*)(lds + PG8_SB(b, h) + boff + n * 2048 + 1024); \
        if constexpr (F8) dst##8[n] = pg8_cat(x0_, x1_); else { dst[n][0] = x0_; dst[n][1] = x1_; } } } while (0)
#define PG8_MMA(ai, bj, At, Bt) do { __builtin_amdgcn_s_setprio(1); if constexpr (F8) { _Pragma("unroll") for (int m = 0; m < 4; ++m) _Pragma("unroll") for (int n = 0; n < 2; ++n) \
        asm volatile("v_mfma_scale_f32_16x16x128_f8f6f4 %0, %1, %2, %0, %3, %3 op_sel_hi:[0,0,0]" : "+v"(acc[ai][bj][m][n]) : "v"(Bt##8[n]), "v"(At##8[m]), "v"(f8scl)); } \
        else { _Pragma("unroll") for (int m = 0; m < 4; ++m) _Pragma("unroll") for (int n = 0; n < 2; ++n) _Pragma("unroll") for (int k = 0; k < 2; ++k) \
        acc[ai][bj][m][n] = __builtin_amdgcn_mfma_f32_16x16x32_bf16(Bt[n][k], At[m][k], acc[ai][bj][m][n], 0, 0, 0); } __builtin_amdgcn_s_setprio(0); } while (0)
#define PG8_WAIT_V(n) asm volatile("s_waitcnt vmcnt(" #n ")" ::: "memory")
#define PG8_WAIT_L(n) asm volatile("s_waitcnt lgkmcnt(" #n ")" ::: "memory")
#define PG8_BAR __builtin_amdgcn_s_barrier()
#define PG8_SCHED __builtin_amdgcn_sched_barrier(0)
    Unit cur, nxt; int ui = 0;
    if (!S.next(0, cur)) return;
    f32x4 acc[2][2][4][2];
#pragma unroll
    for (int a = 0; a < 2; ++a)
#pragma unroll
        for (int b = 0; b < 2; ++b)
#pragma unroll
            for (int m = 0; m < 4; ++m)
#pragma unroll
                for (int n = 0; n < 2; ++n) acc[a][b][m][n] = (f32x4){0.f, 0.f, 0.f, 0.f};
    bf16x8 At[4][2], B0[2][2], B1[2][2]; v8i_t At8[4], B08[2], B18[2]; const int f8scl = 0x7f7f7f7f;
    const char* cA = (const char*)g.A + (size_t)cur.pm * tstep; const char* cB = (const char*)g.Bt + ((size_t)cur.e * g.estride + (size_t)cur.pn * tstep);
    S.a_ready(cur);
    if constexpr (SP2) {
        PG8_STAGE(PG8_SB(0, 0), cB, voffB); PG8_STAGE(PG8_SB(0, 1), cB + hstep, voffB); PG8_STAGE(PG8_SA(0, 0), cA, voffA); PG8_STAGE(PG8_SA(0, 1), cA + hstep, voffA);
        if (wr == 1) PG8_BAR;
        PG8_WAIT_V(2); PG8_BAR;
        PG8_STAGE(PG8_SB(1, 0), cB + kstep, voffB); PG8_STAGE(PG8_SA(1, 0), cA + kstep, voffA); PG8_STAGE(PG8_SB(1, 1), cB + hstep + kstep, voffB);
        PG8_WAIT_V(6); PG8_BAR;
    } else {
        PG8_STAGE(PG8_SB(0, 0), cB, voffB); PG8_STAGE(PG8_SA(0, 0), cA, voffA); PG8_STAGE(PG8_SB(0, 1), cB + hstep, voffB); PG8_STAGE(PG8_SA(0, 1), cA + hstep, voffA);
        if (wr == 1) PG8_BAR;
        PG8_WAIT_V(4); PG8_BAR;
        PG8_STAGE(PG8_SB(1, 0), cB + kstep, voffB); PG8_STAGE(PG8_SA(1, 0), cA + kstep, voffA); PG8_STAGE(PG8_SB(1, 1), cB + hstep + kstep, voffB);
        PG8_WAIT_V(6); PG8_BAR;
    }
    for (;;) {
        const bool has_next = S.next(ui + 1, nxt);
        const char* nA = has_next ? (const char*)g.A + (size_t)nxt.pm * tstep : cA; const char* nB = has_next ? (const char*)g.Bt + ((size_t)nxt.e * g.estride + (size_t)nxt.pn * tstep) : cB;
        for (int t = 0; t < nt; t += 2) {
            const bool last = (t == nt - 2);
            const char* a1 = cA + (size_t)(t + 1) * kstep;
            const char* a2 = last ? nA : cA + (size_t)(t + 2) * kstep; const char* b2 = last ? nB : cB + (size_t)(t + 2) * kstep;
            const char* a3 = a2 + kstep; const char* b3 = b2 + kstep;
            if (last && has_next) S.a_ready(nxt);
            if constexpr (SP2) {
            PG8_LDB(B0, 0, 0); PG8_LDB(B1, 0, 1); PG8_SCHED; PG8_LDA(At, 0, 0); PG8_STAGE(PG8_SA(1, 1), a1 + hstep, voffA);
            PG8_WAIT_V(8); PG8_WAIT_L(0); PG8_BAR; PG8_MMA(0, 0, At, B0); PG8_MMA(0, 1, At, B1); PG8_BAR; PG8_SCHED;
            PG8_LDA(At, 0, 1); PG8_STAGE(PG8_SB(0, 0), b2, voffB); PG8_STAGE(PG8_SB(0, 1), b2 + hstep, voffB); PG8_STAGE(PG8_SA(0, 0), a2, voffA);
            PG8_WAIT_V(8); PG8_WAIT_L(0); PG8_BAR; PG8_MMA(1, 0, At, B0); PG8_MMA(1, 1, At, B1); PG8_BAR; PG8_SCHED;
            PG8_LDB(B0, 1, 0); PG8_LDB(B1, 1, 1); PG8_SCHED; PG8_LDA(At, 1, 0); PG8_STAGE(PG8_SA(0, 1), a2 + hstep, voffA);
            PG8_WAIT_V(8); PG8_WAIT_L(0); PG8_BAR; PG8_MMA(0, 0, At, B0); PG8_MMA(0, 1, At, B1); PG8_BAR; PG8_SCHED;
            PG8_LDA(At, 1, 1); PG8_STAGE(PG8_SB(1, 0), b3, voffB); PG8_STAGE(PG8_SB(1, 1), b3 + hstep, voffB); PG8_STAGE(PG8_SA(1, 0), a3, voffA);
            PG8_WAIT_V(8); PG8_WAIT_L(0); PG8_BAR; PG8_MMA(1, 0, At, B0); PG8_MMA(1, 1, At, B1); PG8_BAR; PG8_SCHED;
            } else {
            PG8_LDB(B0, 0, 0); PG8_SCHED; PG8_LDA(At, 0, 0); PG8_STAGE(PG8_SA(1, 1), a1 + hstep, voffA);
            PG8_WAIT_L(8); PG8_BAR; PG8_WAIT_L(0); PG8_MMA(0, 0, At, B0); PG8_BAR; PG8_SCHED;
            PG8_LDB(B1, 0, 1); PG8_STAGE(PG8_SB(0, 0), b2, voffB);
            PG8_BAR; PG8_WAIT_L(0); PG8_MMA(0, 1, At, B1); PG8_BAR;
            PG8_LDA(At, 0, 1); PG8_STAGE(PG8_SA(0, 0), a2, voffA);
            PG8_BAR; PG8_WAIT_L(0); PG8_MMA(1, 0, At, B0); PG8_BAR; PG8_SCHED;
            PG8_STAGE(PG8_SB(0, 1), b2 + hstep, voffB);
            PG8_WAIT_V(6); PG8_BAR; PG8_MMA(1, 1, At, B1); PG8_BAR;
            PG8_LDB(B0, 1, 0); PG8_SCHED; PG8_LDA(At, 1, 0); PG8_STAGE(PG8_SA(0, 1), a2 + hstep, voffA);
            PG8_WAIT_L(8); PG8_BAR; PG8_WAIT_L(0); PG8_MMA(0, 0, At, B0); PG8_BAR; PG8_SCHED;
            PG8_LDB(B1, 1, 1); PG8_STAGE(PG8_SB(1, 0), b3, voffB);
            PG8_BAR; PG8_WAIT_L(0); PG8_MMA(0, 1, At, B1); PG8_BAR;
            PG8_LDA(At, 1, 1); PG8_STAGE(PG8_SA(1, 0), a3, voffA);
            PG8_BAR; PG8_WAIT_L(0); PG8_MMA(1, 0, At, B0); PG8_BAR; PG8_SCHED;
            PG8_STAGE(PG8_SB(1, 1), b3 + hstep, voffB);
            PG8_WAIT_V(6); PG8_BAR; PG8_MMA(1, 1, At, B1); PG8_BAR;
            }
        }
        if constexpr (F8) { _Pragma("unroll") for (int a_ = 0; a_ < 2; ++a_) _Pragma("unroll") for (int b_ = 0; b_ < 2; ++b_)
            asm volatile("s_nop 15\n\ts_nop 7" : "+v"(acc[a_][b_][0][0]), "+v"(acc[a_][b_][0][1]), "+v"(acc[a_][b_][1][0]), "+v"(acc[a_][b_][1][1]), "+v"(acc[a_][b_][2][0]), "+v"(acc[a_][b_][2][1]), "+v"(acc[a_][b_][3][0]), "+v"(acc[a_][b_][3][1])); }
        if constexpr (ALIGN_EPI) { if (wr == 0) PG8_BAR; }
        if constexpr (!Epi::AFTER_DRAIN) { E(acc, cur, wr, wc, fr, fq); S.done(cur); }
        if (!has_next) break;
#pragma unroll
        for (int a = 0; a < 2; ++a)
#pragma unroll
            for (int b = 0; b < 2; ++b)
#pragma unroll
                for (int m = 0; m < 4; ++m)
#pragma unroll
                    for (int n = 0; n < 2; ++n) acc[a][b][m][n] = (f32x4){0.f, 0.f, 0.f, 0.f};
        cur = nxt; cA = nA; cB = nB; ++ui;
        if constexpr (ALIGN_EPI) { if (wr == 1) PG8_BAR; }
    }
    PG8_WAIT_V(0);
    if constexpr (!ALIGN_EPI) { if (wr == 0) PG8_BAR; }
    PG8_BAR;
    if constexpr (Epi::AFTER_DRAIN) { E.fused(acc, cur, wr, wc, fr, fq, lds, wid, lane); S.done(cur); }
#undef PG8_SA
#undef PG8_SB
#undef PG8_STAGE
#undef PG8_LDA
#undef PG8_LDB
#undef PG8_MMA
#undef PG8_WAIT_V
#undef PG8_WAIT_L
#undef PG8_BAR
#undef PG8_SCHED
}
}

namespace att {
typedef short v4i16_t __attribute__((ext_vector_type(4)));
constexpr int LDS_K = 0, LDS_V = 32768, LDS_WS = 65536, LDS_OST = 67584, LDS_BYTES = LDS_OST + 8 * 8192;
__device__ __forceinline__ int crow(int r, int hi) { return (r & 3) + 8 * (r >> 2) + 4 * hi; }
__device__ __forceinline__ s16x4 vtr(const LAS unsigned char* p) { return __builtin_bit_cast(s16x4, __builtin_amdgcn_ds_read_tr16_b64_v4i16((LAS v4i16_t*)p)); }
__device__ __forceinline__ float xhalf_max(float m) { auto rr = __builtin_amdgcn_permlane32_swap(__float_as_uint(m), __float_as_uint(m), false, false); return fmaxf(__uint_as_float(rr[0]), __uint_as_float(rr[1])); }
__device__ __forceinline__ float xhalf_sum(float m) { auto rr = __builtin_amdgcn_permlane32_swap(__float_as_uint(m), __float_as_uint(m), false, false); return __uint_as_float(rr[0]) + __uint_as_float(rr[1]); }

template <int DQK, int DV, bool CAUSAL>
__device__ __forceinline__ void attn_core(const bf16* Qw, int ldq, const bf16* Kh, int ldk, const bf16* Vh, int ldv, int NT, int qpos0, float slope2,
                                          LAS unsigned char* shm, f32x16 (&o)[DV / 32]) {
    const int tid = threadIdx.x, lane = tid & 63, r32 = lane & 31, hi = lane >> 5; const int wid = __builtin_amdgcn_readfirstlane(tid >> 6);
    LAS float* wsf = (LAS float*)(shm + LDS_WS) + wid * 64;
    constexpr int NKC = DQK / 64, NVP = DV / 64, ND = DQK / 16, NO = DV / 32;
    constexpr float THR = 8.0f;
    bf16x8 qr[ND];
#pragma unroll
    for (int d0 = 0; d0 < ND; ++d0) qr[d0] = *(const bf16x8*)(Qw + (size_t)r32 * ldq + d0 * 16 + hi * 8);
    const bf16* ksrc[NKC]; const bf16* vsrc[NVP];
#pragma unroll
    for (int i = 0; i < NKC; ++i) ksrc[i] = Kh + (size_t)lane * ldk + (wid + 8 * i) * 8;
#pragma unroll
    for (int i = 0; i < NVP; ++i) { const int pc = wid + 8 * i; vsrc[i] = Vh + (size_t)(16 * (pc & 3) + (lane >> 2)) * ldv + (pc >> 2) * 32 + (lane & 3) * 8; }
#define ATT_DMA(t, slot) do { _Pragma("unroll") for (int i = 0; i < NKC; ++i) __builtin_amdgcn_global_load_lds((const unsigned*)(ksrc[i] + (size_t)(t) * 64 * ldk), (LAS unsigned*)(shm + LDS_K + (slot) * 16384 + (wid + 8 * i) * 1024), 16, 0, 0); \
        _Pragma("unroll") for (int i = 0; i < NVP; ++i) __builtin_amdgcn_global_load_lds((const unsigned*)(vsrc[i] + (size_t)(t) * 64 * ldv), (LAS unsigned*)(shm + LDS_V + (slot) * 16384 + (wid + 8 * i) * 1024), 16, 0, 0); } while (0)
    __syncthreads();
    ATT_DMA(0, 0);
    float mref = 0.f, l = 0.f;
#pragma unroll
    for (int d = 0; d < NO; ++d) o[d] = f32x16{};
    float bz[16];
#pragma unroll
    for (int r = 0; r < 16; ++r) bz[r] = slope2 * (float)crow(r, hi);
    const float qf = (float)(qpos0 + r32);
    const LAS unsigned char* kb0 = shm + LDS_K + hi * 1024 + r32 * 16;
    const LAS unsigned char* vp0 = shm + LDS_V + ((lane >> 4) & 1) * 32 + (lane & 3) * 8 + (4 * hi + ((lane & 15) >> 2)) * 64;
    asm volatile("s_waitcnt vmcnt(0)" ::: "memory"); __syncthreads();
    for (int t = 0; t < NT; ++t) {
        const int slot = t & 1;
        if (t + 1 < NT) ATT_DMA(t + 1, slot ^ 1);
        const bool active = !CAUSAL || (64 * t <= qpos0 + 31);
        if (active) {
            const LAS unsigned char* kb = kb0 + slot * 16384; const LAS unsigned char* vp = vp0 + slot * 16384;
            f32x16 p0, p1;
            const float tb = slope2 * ((float)(64 * t) - qf) - mref;
#pragma unroll
            for (int r = 0; r < 16; ++r) { p0[r] = bz[r] + tb; p1[r] = bz[r] + (tb + 32.0f * slope2); }
#pragma unroll
            for (int d0 = 0; d0 < ND; ++d0) {
                const bf16x8 b0 = *(const LAS bf16x8*)(kb + d0 * 2048), b1 = *(const LAS bf16x8*)(kb + d0 * 2048 + 512);
                p0 = __builtin_amdgcn_mfma_f32_32x32x16_bf16(b0, qr[d0], p0, 0, 0, 0);
                p1 = __builtin_amdgcn_mfma_f32_32x32x16_bf16(b1, qr[d0], p1, 0, 0, 0);
            }
            if (CAUSAL && (64 * t + 63 > qpos0)) {
                const int q = qpos0 + r32;
#pragma unroll
                for (int r = 0; r < 16; ++r) { const int kv = 64 * t + crow(r, hi); if (kv > q) p0[r] = -INFINITY; if (kv + 32 > q) p1[r] = -INFINITY; }
            }
            float ra = fmaxf(fmaxf(p0[0], p0[1]), p1[0]), rb = fmaxf(fmaxf(p0[2], p0[3]), p1[1]);
            ra = fmaxf(fmaxf(ra, p1[2]), p1[3]);
#pragma unroll
            for (int r = 4; r < 16; r += 4) { ra = fmaxf(fmaxf(ra, p0[r]), p0[r + 1]); rb = fmaxf(fmaxf(rb, p0[r + 2]), p0[r + 3]); ra = fmaxf(fmaxf(ra, p1[r]), p1[r + 1]); rb = fmaxf(fmaxf(rb, p1[r + 2]), p1[r + 3]); }
            float rm = xhalf_max(fmaxf(ra, rb));
            if (true) {
                const float dl = fmaxf(rm, 0.f); mref += dl;
#pragma unroll
                for (int r = 0; r < 16; ++r) { p0[r] -= dl; p1[r] -= dl; }
                const float f = fast_exp2(-dl); l *= f;
                if (hi == 0) wsf[r32] = f;
#pragma unroll
                for (int r = 0; r < 16; ++r) { const float fr = wsf[crow(r, hi)];
#pragma unroll
                    for (int d = 0; d < NO; ++d) o[d][r] *= fr; }
            }
            float s0 = 0.f, s1 = 0.f;
#pragma unroll
            for (int r = 0; r < 16; ++r) { p0[r] = fast_exp2(p0[r]); p1[r] = fast_exp2(p1[r]); s0 += p0[r]; s1 += p1[r]; }
            l += s0 + s1;
            bf16x8 pa[4];
#pragma unroll
            for (int ks = 0; ks < 4; ++ks) { u32x4 w;
#pragma unroll
                for (int j = 0; j < 4; ++j) { const int b = 8 * (ks & 1) + 2 * j; w[j] = (ks < 2) ? cvt_pk_bf16(p0[b], p0[b + 1]) : cvt_pk_bf16(p1[b], p1[b + 1]); }
                pa[ks] = __builtin_bit_cast(bf16x8, w); }
#pragma unroll
            for (int d0 = 0; d0 < NO; ++d0) {
#pragma unroll
                for (int ks = 0; ks < 4; ++ks) {
                    const s16x4 lo = vtr(vp + d0 * 4096 + ks * 1024), hh = vtr(vp + d0 * 4096 + ks * 1024 + 512);
                    const bf16x8 vf = (bf16x8){lo[0], lo[1], lo[2], lo[3], hh[0], hh[1], hh[2], hh[3]};
                    o[d0] = __builtin_amdgcn_mfma_f32_32x32x16_bf16(pa[ks], vf, o[d0], 0, 0, 0);
                }
                __builtin_amdgcn_sched_barrier(0);
            }
        }
        asm volatile("s_waitcnt vmcnt(0)" ::: "memory"); __syncthreads();
    }
#undef ATT_DMA
    l = xhalf_sum(l);
    if (hi == 0) wsf[32 + r32] = fast_rcp(l);
#pragma unroll
    for (int r = 0; r < 16; ++r) { const float f = wsf[32 + crow(r, hi)];
#pragma unroll
        for (int d = 0; d < NO; ++d) o[d][r] *= f; }
}
__device__ __forceinline__ void store_o128(const f32x16 (&o)[4], bf16* Ow, int ldo, LAS unsigned char* shm) {
    const int tid = threadIdx.x, lane = tid & 63, r32 = lane & 31, hi = lane >> 5; const int wid = __builtin_amdgcn_readfirstlane(tid >> 6);
    LAS bf16* stg = (LAS bf16*)(shm + LDS_OST + wid * 8192);
#pragma unroll
    for (int r = 0; r < 16; ++r) { const int orow = crow(r, hi);
#pragma unroll
        for (int d0 = 0; d0 < 4; ++d0) stg[orow * 128 + d0 * 32 + r32] = (bf16)(cvt_pk_bf16(o[d0][r], 0.f) & 0xffffu); }
#pragma unroll
    for (int i = 0; i < 8; ++i) { const int row = i * 4 + (lane >> 4), ch = lane & 15; const u32x4 v = *(const LAS u32x4*)(stg + row * 128 + ch * 8); *(u32x4*)(Ow + (size_t)row * ldo + ch * 8) = v; }
}
}

constexpr int NWAVES = 8;
constexpr int BATCH = 8, T = 4096, D = 1024, M = BATCH * T;
constexpr int DZ = 2560, DCAT = 1536, FF = 3584, NKVQ = 3584, NEXP = 8, MEMT = 256, MEMROWS = BATCH * MEMT;
constexpr int MOE_ROWS = 2 * M + NEXP * 256;
constexpr int NSLOT = M / 16;
constexpr float LN_EPS = 1e-5f, DN_ALPHA = 1.41421356237f;
constexpr float LOG2E = 1.4426950408889634f;
constexpr float C2Q = 0.125f * LOG2E;
constexpr float C2M = 0.08838834764831845f * LOG2E;
constexpr float WSC13 = 32.f, WSC2 = 128.f, HSC = 8.f;
constexpr float LAM_INIT = 0.35550906759f;

constexpr size_t MiB = 1u << 20;
constexpr size_t WS_CTL = 0, CTL_ZERO_BYTES = 64 * 1024;
constexpr size_t WS_WZ = 1 * MiB, WS_WO0 = 6 * MiB, WS_W13 = 9 * MiB, WS_W2 = 23 * MiB, WS_WMKV = 30 * MiB, WS_WKVQ = 34 * MiB, WS_WO1 = 41 * MiB, WS_WG = 44 * MiB,
                 WS_WM13 = 45 * MiB, WS_WM2 = 157 * MiB;
constexpr size_t WS_ROUTE = 213 * MiB;
constexpr size_t RT_E = WS_ROUTE, RT_G = RT_E + (size_t)M * 4, RT_WCNT = RT_G + (size_t)M * 8, RT_STOK = RT_WCNT + NSLOT * 8 * 4, RT_SGATE = RT_STOK + (size_t)MOE_ROWS * 4,
                 RT_TDEST = RT_SGATE + (size_t)MOE_ROWS * 4, RT_TILEE = RT_TDEST + (size_t)M * 8, RT_META = RT_TILEE + 2048, RT_END = RT_META + 256;
static_assert(RT_END <= 215 * MiB, "route region");
constexpr size_t WS_AGG = 215 * MiB, WS_MKV = 216 * MiB, WS_MEMB = 224 * MiB;
constexpr size_t WS_H3 = 228 * MiB, WS_STASH = 228 * MiB;
constexpr size_t WS_BIG = 292 * MiB;
constexpr size_t WS_XB = WS_BIG, WS_ZG = WS_BIG + 64 * MiB, WS_U = WS_BIG + 128 * MiB, WS_QM0 = WS_BIG + 192 * MiB;
constexpr size_t WS_CAT = WS_BIG + 224 * MiB, WS_Y = WS_BIG + 320 * MiB, WS_H1 = WS_BIG + 448 * MiB, WS_H2 = WS_BIG + 512 * MiB;
constexpr size_t WS_HID = WS_BIG, WS_K = WS_BIG, WS_V = WS_BIG + 64 * MiB, WS_QD = WS_BIG + 128 * MiB, WS_QM1 = WS_BIG + 192 * MiB;
constexpr size_t WS_HIDM = WS_BIG, WS_AG = WS_BIG + 462 * MiB, WS_Y2 = WS_AG, WS_END = WS_AG + 132 * MiB;
static_assert((size_t)MOE_ROWS * FF * 2 <= 462 * MiB && (size_t)MOE_ROWS * D * 2 <= 132 * MiB, "moe buffers");
constexpr int CW_TMO = 0, CW_CODE = 1, CW_BAR = 4096;

constexpr int RING_OFF = 0, RING_BYTES = 131072, XTRA_OFF = 131072, XTRA_BYTES = 24576, LDSCTL_OFF = XTRA_OFF + XTRA_BYTES, LDS_BYTES = LDSCTL_OFF + 512;

typedef GAS unsigned gu32;
#define RLX_AGENT __ATOMIC_RELAXED, __HIP_MEMORY_SCOPE_AGENT
#define LDS_WAIT() asm volatile("s_waitcnt lgkmcnt(0)" ::: "memory")
#define VM_WAIT() asm volatile("s_waitcnt vmcnt(0)" ::: "memory")
__device__ __forceinline__ unsigned f2bf(float f) { unsigned u = __builtin_bit_cast(unsigned, f); return (u + 0x7fffu + ((u >> 16) & 1u)) >> 16; }
__device__ __forceinline__ unsigned pk2(float lo, float hi) { return f2bf(lo) | (f2bf(hi) << 16); }
__device__ __forceinline__ float wave_sum(float v) {
#pragma unroll
    for (int o = 1; o < 64; o <<= 1) v += __shfl_xor(v, o);
    return v;
}

#define XB_TMO      128
#define XB_XCNT(j)  (256  + 64 * (j))
#define XB_XSUB(j)  (1280 + 64 * (j))
#define XB_XGEN(j)  (2304 + 64 * (j))
#define XB_TOP      3328
#define XB_TOPGEN   3392
#define XCD_BAR_WORDS 3456
#define XB_SPIN_CAP (1u << 18)

__device__ __forceinline__ unsigned xb_ld(unsigned* p)              { return __hip_atomic_load(p, __ATOMIC_RELAXED, __HIP_MEMORY_SCOPE_AGENT); }
__device__ __forceinline__ unsigned xb_add(unsigned* p, unsigned v) { return __hip_atomic_fetch_add(p, v, __ATOMIC_RELAXED, __HIP_MEMORY_SCOPE_AGENT); }
__device__ __forceinline__ unsigned xb_xcc_id() { return (unsigned)__builtin_amdgcn_s_getreg((3 << 11) | 20) & 0xFu; }
#define XB_SPIN(cond, bar) do { unsigned _sp = 0; while (cond) { __builtin_amdgcn_s_sleep(1); \
    if ((++_sp & 255u) == 0u) { if (xb_ld(&(bar)[XB_TMO])) break; if (_sp > XB_SPIN_CAP) { atomicAdd(&(bar)[XB_TMO], 1u); break; } } } } while (0)

struct XcdBarrier {
    unsigned* bar; unsigned x;
    volatile LAS unsigned* st;
};

__device__ __forceinline__ XcdBarrier xcd_barrier_post(unsigned* bar, volatile LAS unsigned* st) {
    XcdBarrier b; b.bar = bar; b.x = xb_xcc_id(); b.st = st;
    if (threadIdx.x == 0) (void)xb_add(&bar[XB_XCNT(b.x)], 1u);
    return b;
}
__device__ __forceinline__ void xcd_barrier_complete(unsigned* bar, unsigned x, unsigned& nloc, unsigned& nx) {
    const unsigned G = gridDim.x * gridDim.y * gridDim.z;
    unsigned sum, cnt, mine, sp = 0u;
    for (;;) {
        sum = 0u; cnt = 0u; mine = 0u;
#pragma unroll
        for (unsigned j = 0; j < 16; ++j) { const unsigned c = xb_ld(&bar[XB_XCNT(j)]); sum += c; cnt += (c > 0u) ? 1u : 0u; mine = (j == x) ? c : mine; }
        if (sum == G) break;
        __builtin_amdgcn_s_sleep(1);
        if ((++sp & 255u) == 0u) { if (xb_ld(&bar[XB_TMO])) break; if (sp > XB_SPIN_CAP) { atomicAdd(&bar[XB_TMO], 1u); break; } }
    }
    nloc = mine > 0u ? mine : 1u; nx = cnt > 0u ? cnt : 1u;
}

__device__ __forceinline__ void xcd_barrier(const XcdBarrier& b) {
    asm volatile("s_waitcnt vmcnt(0)" ::: "memory");
    __syncthreads();
    if (threadIdx.x == 0) {
        unsigned* bar = b.bar;
        __builtin_amdgcn_s_waitcnt(0);
        unsigned nloc = b.st[0], nx = b.st[1];
        if (nloc == 0u) { xcd_barrier_complete(bar, b.x, nloc, nx); b.st[0] = nloc; b.st[1] = nx; }
        const unsigned old = xb_add(&bar[XB_XSUB(b.x)], 1u);
        const unsigned gen = old / nloc;
        if (old + 1u == (gen + 1u) * nloc) {
            __builtin_amdgcn_fence(__ATOMIC_RELEASE, "agent");
            asm volatile("s_waitcnt vmcnt(0)" ::: "memory");
            const unsigned og = xb_add(&bar[XB_TOP], 1u);
            const unsigned tg = og / nx;
            if (og + 1u == (tg + 1u) * nx) xb_add(&bar[XB_TOPGEN], 1u);
            else XB_SPIN(xb_ld(&bar[XB_TOPGEN]) == tg, bar);
            __builtin_amdgcn_fence(__ATOMIC_ACQUIRE, "agent");
            xb_add(&bar[XB_XGEN(b.x)], 1u);
            asm volatile("s_waitcnt vmcnt(0)" ::: "memory");
        } else {
            XB_SPIN(xb_ld(&bar[XB_XGEN(b.x)]) == gen, bar);
            __builtin_amdgcn_fence(__ATOMIC_ACQUIRE, "agent");
            asm volatile("s_waitcnt vmcnt(0)" ::: "memory");
        }
    }
    __syncthreads();
}

enum { IN_X = 0, IN_MEM, IN_A_W_IN, IN_A_CONV_W, IN_A_CONV_B, IN_A_W_RG, IN_A_B_RG, IN_A_W_IG, IN_A_B_IG, IN_A_LAMBDA, IN_A_W_OUT, IN_W_KV, IN_B_W_Q, IN_B_LAMBDA, IN_B_SUBLN,
       IN_B_W_OUT, IN_MEM_W_KV, IN_FFN_W13, IN_FFN_W2, IN_MOE_ROUTER, IN_MOE_W13, IN_MOE_W2, IN_LN_G, IN_LN_B, N_IN };
struct Args { const float* in[N_IN]; float* out; unsigned char* ws; int ph_lo, ph_hi; };
constexpr int N_PHASES = 17;


namespace pg8 {
template <int MODE> struct EpiSegT {
    static constexpr bool PERM = true, AFTER_DRAIN = false;
    unsigned char* ws;
    __device__ __forceinline__ void operator()(const f32x4 (&acc)[2][2][4][2], const Unit& u, int wr, int wc, int fr, int fq) const {
        size_t off; int ldc, ts; float scl; bool act = false;
        if (MODE == 0) { if (u.pn < 4) { off = WS_ZG; ldc = D; ts = 0; scl = 1.f; act = true; } else if (u.pn < 8) { off = WS_U; ldc = D; ts = 4; scl = 1.f; } else { off = WS_QM0; ldc = 512; ts = 8; scl = C2M; } }
        else if (MODE == 1) { off = WS_MKV; ldc = 2 * D; ts = 0; scl = 1.f; }
        else { if (u.pn < 4) { off = WS_K; ldc = D; ts = 0; scl = 1.f; } else if (u.pn < 8) { off = WS_V; ldc = D; ts = 4; scl = 1.f; } else if (u.pn < 12) { off = WS_QD; ldc = D; ts = 8; scl = C2Q; } else { off = WS_QM1; ldc = 512; ts = 12; scl = C2M; } }
        bf16_t* base = (bf16_t*)(ws + off);
        const int row0 = u.pm * BM + wr * 64 + fr, col0 = (u.pn - ts) * BM + wc * 32 + 8 * fq;
#pragma unroll
        for (int ai = 0; ai < 2; ++ai)
#pragma unroll
            for (int m = 0; m < 4; ++m) { bf16_t* rowp = base + (size_t)(row0 + ai * HALF + m * 16) * ldc + col0;
#pragma unroll
                for (int bj = 0; bj < 2; ++bj) { f32x4 v0 = acc[ai][bj][m][0], v1 = acc[ai][bj][m][1];
                    if (act) {
#pragma unroll
                        for (int j = 0; j < 4; ++j) { v0[j] = gelu_tanh(v0[j]); v1[j] = gelu_tanh(v1[j]); } }
                    v0 = v0 * scl; v1 = v1 * scl;
                    u32x4 w; w.x = cvt_pk_bf16(v0[0], v0[1]); w.y = cvt_pk_bf16(v0[2], v0[3]); w.z = cvt_pk_bf16(v1[0], v1[1]); w.w = cvt_pk_bf16(v1[2], v1[3]);
                    *(u32x4*)(rowp + bj * HALF) = w; } }
    }
};
}

__device__ __forceinline__ void p0_transpose_item(const float* W, int K, int N, bf16* WT, int k0, int n0, int drow0, LAS float* scr, int lane) {
    float v[32];
#pragma unroll
    for (int i = 0; i < 32; ++i) { const int kk = 2 * i + (lane >> 5); v[i] = W[(size_t)(k0 + kk) * N + n0 + (lane & 31)]; }
#pragma unroll
    for (int i = 0; i < 32; ++i) { const int kk = 2 * i + (lane >> 5); scr[kk * 33 + (lane & 31)] = v[i]; }
    LDS_WAIT(); asm volatile("" ::: "memory");
    const int c = lane & 7;
#pragma unroll
    for (int j = 0; j < 4; ++j) { const int n = (lane >> 3) + 8 * j; const LAS float* s = scr + (8 * c) * 33 + n;
        u32x4 o; o.x = pk2(s[0 * 33], s[1 * 33]); o.y = pk2(s[2 * 33], s[3 * 33]); o.z = pk2(s[4 * 33], s[5 * 33]); o.w = pk2(s[6 * 33], s[7 * 33]);
        *(u32x4*)(WT + (size_t)(drow0 + n) * K + k0 + 8 * c) = o; }
    LDS_WAIT(); asm volatile("" ::: "memory");
}
__device__ __forceinline__ void p0_job(const float* W, int K, int N, bf16* WT, int mode, int row_off, int& base, int gw, int NGW, LAS float* scr, int lane) {
    const int nblk = N / 32, nitems = (K / 64) * nblk;
    int it0 = (gw - (base % NGW) + NGW) % NGW;
    for (int it = it0; it < nitems; it += NGW) {
        const int kb = it / nblk, nb = it % nblk, n0 = 32 * nb;
        int drow0;
        if (mode == 0) drow0 = row_off + n0;
        else { const int isu = n0 >= FF, nn = isu ? n0 - FF : n0; drow0 = 256 * (nn / 128) + 128 * isu + (nn % 128); }
        p0_transpose_item(W, K, N, WT, 64 * kb, n0, drow0, scr, lane);
    }
    base += nitems;
}

__device__ __forceinline__ void p0_transpose_item_f8(const float* W, int K, int N, unsigned char* WT, int k0, int n0, int drow0, float sc, LAS float* scr, int lane) {
    float v[32];
#pragma unroll
    for (int i = 0; i < 32; ++i) { const int kk = 2 * i + (lane >> 5); v[i] = W[(size_t)(k0 + kk) * N + n0 + (lane & 31)]; }
#pragma unroll
    for (int i = 0; i < 32; ++i) { const int kk = 2 * i + (lane >> 5); scr[kk * 33 + (lane & 31)] = v[i]; }
    LDS_WAIT(); asm volatile("" ::: "memory");
    const int n = lane >> 1, hf = lane & 1; const LAS float* s = scr + (32 * hf) * 33 + n;
    u32x4 o0, o1;
#pragma unroll
    for (int q = 0; q < 4; ++q) { o0[q] = pg8::cvt4_fp8(s[(4 * q) * 33] * sc, s[(4 * q + 1) * 33] * sc, s[(4 * q + 2) * 33] * sc, s[(4 * q + 3) * 33] * sc);
        o1[q] = pg8::cvt4_fp8(s[(16 + 4 * q) * 33] * sc, s[(16 + 4 * q + 1) * 33] * sc, s[(16 + 4 * q + 2) * 33] * sc, s[(16 + 4 * q + 3) * 33] * sc); }
    unsigned char* dst = WT + (size_t)(drow0 + n) * K + k0 + 32 * hf;
    *(u32x4*)dst = o0; *(u32x4*)(dst + 16) = o1;
    LDS_WAIT(); asm volatile("" ::: "memory");
}
__device__ __forceinline__ void p0_job_f8(const float* W, int K, int N, unsigned char* WT, int mode, int row_off, float sc, int& base, int gw, int NGW, LAS float* scr, int lane) {
    const int nblk = N / 32, nitems = (K / 64) * nblk;
    int it0 = (gw - (base % NGW) + NGW) % NGW;
    for (int it = it0; it < nitems; it += NGW) {
        const int kb = it / nblk, nb = it % nblk, n0 = 32 * nb;
        int drow0;
        if (mode == 0) drow0 = row_off + n0;
        else { const int isu = n0 >= FF, nn = isu ? n0 - FF : n0; drow0 = 256 * (nn / 128) + 128 * isu + (nn % 128); }
        p0_transpose_item_f8(W, K, N, WT, 64 * kb, n0, drow0, sc, scr, lane);
    }
    base += nitems;
}
__device__ __forceinline__ void p0_cvt_rows(const float* X, bf16* XB, size_t n8, size_t gtid, size_t nthreads) {
    for (size_t i = gtid; i < n8; i += nthreads) { const f32x4 a = *(const f32x4*)(X + i * 8), b = *(const f32x4*)(X + i * 8 + 4);
        u32x4 o; o.x = pk2(a[0], a[1]); o.y = pk2(a[2], a[3]); o.z = pk2(b[0], b[1]); o.w = pk2(b[2], b[3]); *(u32x4*)(XB + i * 8) = o; }
}

template <int NR> __device__ __forceinline__ void wave_sum_n(float (&x)[NR]) {
#pragma unroll
    for (int o = 1; o < 64; o <<= 1) {
#pragma unroll
        for (int i = 0; i < NR; ++i) x[i] += __shfl_xor(x[i], o); }
}
template <int NR, bool HPF32, bool ADD2>
__device__ __forceinline__ void ln_rows(const float* Y, const void* HP, const bf16* Y2, const int* tdest, size_t m0, const float* g, const float* b, bf16* OB, float* OF, f32x4 (&v)[NR][4], int lane, unsigned char* O8 = nullptr) {
#pragma unroll
    for (int i = 0; i < NR; ++i) {
        const size_t m = m0 + i;
        const bf16 *a0 = nullptr, *a1 = nullptr;
        if (ADD2) { const int d0 = __builtin_amdgcn_readfirstlane(tdest[2 * m]), d1 = __builtin_amdgcn_readfirstlane(tdest[2 * m + 1]); a0 = Y2 + (size_t)d0 * D; a1 = Y2 + (size_t)d1 * D; }
#pragma unroll
        for (int j = 0; j < 4; ++j) {
            f32x4 h;
            if (HPF32) h = *((const f32x4*)((const float*)HP + m * D) + lane + 64 * j);
            else { const u32x2 w = *((const u32x2*)((const bf16*)HP + m * D) + lane + 64 * j); h = (f32x4){bflo(w.x), bfhi(w.x), bflo(w.y), bfhi(w.y)}; }
            f32x4 y;
            if (ADD2) { const u32x2 w0 = *((const u32x2*)a0 + lane + 64 * j), w1 = *((const u32x2*)a1 + lane + 64 * j);
                y = (f32x4){bflo(w0.x) + bflo(w1.x), bfhi(w0.x) + bfhi(w1.x), bflo(w0.y) + bflo(w1.y), bfhi(w0.y) + bfhi(w1.y)}; }
            else y = *((const f32x4*)(Y + m * D) + lane + 64 * j);
            v[i][j] = h * DN_ALPHA + y;
        }
    }
    float s[NR];
#pragma unroll
    for (int i = 0; i < NR; ++i) { s[i] = 0.f;
#pragma unroll
        for (int j = 0; j < 4; ++j) s[i] += (v[i][j].x + v[i][j].y) + (v[i][j].z + v[i][j].w); }
    wave_sum_n<NR>(s);
    float s2[NR];
#pragma unroll
    for (int i = 0; i < NR; ++i) { const float mean = s[i] * (1.f / D); s2[i] = 0.f;
#pragma unroll
        for (int j = 0; j < 4; ++j) { v[i][j] = v[i][j] - mean; s2[i] += (v[i][j].x * v[i][j].x + v[i][j].y * v[i][j].y) + (v[i][j].z * v[i][j].z + v[i][j].w * v[i][j].w); } }
    wave_sum_n<NR>(s2);
#pragma unroll
    for (int j = 0; j < 4; ++j) { const f32x4 gg = *((const f32x4*)g + lane + 64 * j), bb = *((const f32x4*)b + lane + 64 * j);
#pragma unroll
        for (int i = 0; i < NR; ++i) { const size_t m = m0 + i; const float rstd = 1.f / sqrtf(s2[i] * (1.f / D) + LN_EPS);
            v[i][j] = v[i][j] * rstd * gg + bb;
            if (OB) { u32x2 w; w.x = pk2(v[i][j].x, v[i][j].y); w.y = pk2(v[i][j].z, v[i][j].w); *((u32x2*)(OB + m * D) + lane + 64 * j) = w; }
            if (O8) *((unsigned*)(O8 + m * D) + lane + 64 * j) = pg8::cvt4_fp8(v[i][j].x, v[i][j].y, v[i][j].z, v[i][j].w);
            if (OF) *((f32x4*)(OF + m * D) + lane + 64 * j) = v[i][j]; } }
}

constexpr float LOG2E_ = 1.4426950408889634f;
__device__ __forceinline__ int scan_row(int tl) { return 32 * (tl >> 5) + att::crow(tl & 15, (tl >> 4) & 1); }
__device__ __forceinline__ void scan_unit(int pass, int b, int n, int c, bool loadW, const bf16* U, const bf16* ZG, bf16* CAT, const bf16* Wg, f32x2* agg,
                                          const float* conv_w, const float* conv_b, const float* b_rg, const float* b_ig, const float* lam, LAS unsigned char* lds) {
    const int tid = threadIdx.x, lane = tid & 63, r32 = lane & 31, hi = lane >> 5; const int wv = __builtin_amdgcn_readfirstlane(tid >> 6);
    LAS unsigned char* At = lds; LAS unsigned char* Wt = lds + 65536;
    LAS f32x2* comp = (LAS f32x2*)(lds + XTRA_OFF);
    LAS float* cin = (LAS float*)(lds + XTRA_OFF + 8192);
    const int t0 = c * 256; const size_t rowbase = (size_t)b * T + t0;
    __syncthreads();
    if (loadW) {
        for (int i = tid; i < 4096; i += 512) { const int row = i >> 4, c16 = i & 15; const u32x4 v = *(const u32x4*)(Wg + ((size_t)n * 256 + row) * 128 + c16 * 8);
            *(LAS u32x4*)(Wt + row * 256 + ((c16 ^ (row & 15)) << 4)) = v; }
    }
    {
        const int ch8 = tid & 15, tg = tid >> 4, chb = n * 128 + ch8 * 8;
        float cw[4][8], cb[8];
#pragma unroll
        for (int j = 0; j < 4; ++j) { const f32x4 a = *(const f32x4*)(conv_w + j * D + chb), bq = *(const f32x4*)(conv_w + j * D + chb + 4);
            cw[j][0] = a[0]; cw[j][1] = a[1]; cw[j][2] = a[2]; cw[j][3] = a[3]; cw[j][4] = bq[0]; cw[j][5] = bq[1]; cw[j][6] = bq[2]; cw[j][7] = bq[3]; }
        { const f32x4 a = *(const f32x4*)(conv_b + chb), bq = *(const f32x4*)(conv_b + chb + 4); cb[0] = a[0]; cb[1] = a[1]; cb[2] = a[2]; cb[3] = a[3]; cb[4] = bq[0]; cb[5] = bq[1]; cb[6] = bq[2]; cb[7] = bq[3]; }
        u32x4 uw[11];
#pragma unroll
        for (int k = 0; k < 11; ++k) { const int tt = tg * 8 - 3 + k; uw[k] = (u32x4){0u, 0u, 0u, 0u};
            if (t0 + tt >= 0) uw[k] = *(const u32x4*)(U + (size_t)((long)rowbase + tt) * D + chb); }
#pragma unroll
        for (int k = 0; k < 8; ++k) { float rr[8];
#pragma unroll
            for (int e = 0; e < 8; ++e) rr[e] = cb[e];
#pragma unroll
            for (int j = 0; j < 4; ++j) { const u32x4 w = uw[k + j];
                rr[0] += cw[j][0] * bflo(w.x); rr[1] += cw[j][1] * bfhi(w.x); rr[2] += cw[j][2] * bflo(w.y); rr[3] += cw[j][3] * bfhi(w.y);
                rr[4] += cw[j][4] * bflo(w.z); rr[5] += cw[j][5] * bfhi(w.z); rr[6] += cw[j][6] * bflo(w.w); rr[7] += cw[j][7] * bfhi(w.w); }
            const int tl = tg * 8 + k, row = scan_row(tl);
            u32x4 w; w.x = pk2(rr[0], rr[1]); w.y = pk2(rr[2], rr[3]); w.z = pk2(rr[4], rr[5]); w.w = pk2(rr[6], rr[7]);
            *(LAS u32x4*)(At + row * 256 + ((ch8 ^ (row & 15)) << 4)) = w; }
    }
    if (pass == 2 && tid < 128) { float H = 0.f; for (int cc = 0; cc < c; ++cc) { const f32x2 ab = agg[((size_t)(b * 16 + cc)) * D + n * 128 + tid]; H = ab.x * H + ab.y; } cin[tid] = H; }
    __syncthreads();
    bf16x8 af[8];
#pragma unroll
    for (int ks = 0; ks < 8; ++ks) { const int row = 32 * wv + r32; af[ks] = *(const LAS bf16x8*)(At + row * 256 + (((2 * ks + hi) ^ (row & 15)) << 4)); }
#pragma unroll 1
    for (int q = 0; q < 4; ++q) {
        f32x16 aR = f32x16{}, aI = f32x16{};
#pragma unroll
        for (int ks = 0; ks < 8; ++ks) { const int brow = 32 * q + r32;
            const bf16x8 bR = *(const LAS bf16x8*)(Wt + brow * 256 + (((2 * ks + hi) ^ (brow & 15)) << 4));
            const bf16x8 bI = *(const LAS bf16x8*)(Wt + (brow + 128) * 256 + (((2 * ks + hi) ^ (brow & 15)) << 4));
            aR = __builtin_amdgcn_mfma_f32_32x32x16_bf16(af[ks], bR, aR, 0, 0, 0);
            aI = __builtin_amdgcn_mfma_f32_32x32x16_bf16(af[ks], bI, aI, 0, 0, 0); }
        const int chl = 32 * q + r32, ch = n * 128 + chl;
        const float br = b_rg[ch], bi = b_ig[ch], cl = -8.0f * log1pf(__expf(-lam[ch]));
        float h = 0.f, cum = 1.f;
#pragma unroll
        for (int r = 0; r < 16; ++r) {
            const int row = 32 * wv + att::crow(r, hi), tl = 32 * wv + 16 * hi + r;
            const float recv = bf2f(*(const LAS unsigned short*)(At + row * 256 + ((((chl >> 3) ^ (row & 15)) << 4)) + (chl & 7) * 2));
            const float rg = sigmoidf_(aR[r] + br), ig = sigmoidf_(aI[r] + bi);
            const float la = cl * rg, a = fast_exp2(LOG2E_ * la); float mult = sqrtf(fmaxf(1.0f - a * a, 0.f));
            if (c == 0 && tl == 0) mult = 1.0f;
            h = a * h + mult * ig * recv; cum *= a; aI[r] = h; aR[r] = cum;
        }
        const float pc = __shfl_xor(cum, 32), ph = __shfl_xor(h, 32);
        const float loc = hi ? pc : cum, loh = hi ? ph : h, hic = hi ? cum : pc, hih = hi ? h : ph;
        LAS f32x2* cq = comp + (q & 1) * 256;
        if (hi == 0) cq[wv * 32 + r32] = (f32x2){loc * hic, hic * loh + hih};
        __syncthreads();
        if (pass == 1) {
            if (tid < 32) { float A = 1.f, B = 0.f;
#pragma unroll
                for (int w = 0; w < 8; ++w) { const f32x2 ab = cq[w * 32 + tid]; B = ab.x * B + ab.y; A = ab.x * A; }
                agg[((size_t)(b * 16 + c)) * D + n * 128 + 32 * q + tid] = (f32x2){A, B}; }
        } else {
            float H = cin[chl];
            for (int w = 0; w < wv; ++w) { const f32x2 ab = cq[w * 32 + r32]; H = ab.x * H + ab.y; }
            if (hi) H = loc * H + loh;
            const bf16* zgb = ZG + rowbase * D + n * 128; bf16* catb = CAT + rowbase * DCAT + n * 128;
            const unsigned tl0 = 32 * wv + 16 * hi;
#pragma unroll
            for (int r = 0; r < 16; ++r) { const unsigned tl = tl0 + r;
                const float hv = aI[r] + aR[r] * H; const float gt = bf2f(zgb[tl * (unsigned)D + (unsigned)chl]);
                catb[tl * (unsigned)DCAT + (unsigned)chl] = (bf16)f2bf(hv * gt); }
        }
    }
}

__global__ void __launch_bounds__(NWAVES * 64, 2) yoco_fwd(Args args) {
    extern __shared__ __attribute__((aligned(16))) unsigned char lds_raw[];
    LAS unsigned char* lds = (LAS unsigned char*)lds_raw;
    const int tid = threadIdx.x, lane = tid & 63; const int wave = __builtin_amdgcn_readfirstlane(tid >> 6);
    const int G = gridDim.x, bx = blockIdx.x;
    const int gw = bx * NWAVES + wave, NGW = G * NWAVES;
    unsigned char* ws = args.ws;
    gu32* ctl = (gu32*)(ws + WS_CTL);
    for (int u = tid; u < (LDS_BYTES - LDSCTL_OFF) / 4; u += NWAVES * 64) ((LAS unsigned*)(lds + LDSCTL_OFF))[u] = 0u;
    __syncthreads();
    XcdBarrier bar = xcd_barrier_post((unsigned*)(ctl + CW_BAR), (volatile LAS unsigned*)(lds + LDSCTL_OFF) + 8);
    const int lo = args.ph_lo, hi_ph = args.ph_hi;
#ifndef PH_MASK
#define PH_MASK 0x1ffff
#endif
#define IN(k) ((((PH_MASK) >> (k)) & 1) && lo <= (k) && (k) < hi_ph)
#define SEAM(k) do { if (IN(k) && IN((k) + 1)) xcd_barrier(bar); } while (0)
#ifndef PROBE_DUP
#define PROBE_DUP (-1)
#endif
#define PH_BEGIN(k) if (IN(k)) for (int rep_ = 0; rep_ < ((PROBE_DUP) == (k) ? 2 : 1); ++rep_) if (rep_ == 0 || (xcd_barrier(bar), true))

    bf16* WZ = (bf16*)(ws + WS_WZ); bf16* WO0 = (bf16*)(ws + WS_WO0); bf16* W13 = (bf16*)(ws + WS_W13); bf16* W2 = (bf16*)(ws + WS_W2); bf16* WMKV = (bf16*)(ws + WS_WMKV);
    bf16* WKVQ = (bf16*)(ws + WS_WKVQ); bf16* WO1 = (bf16*)(ws + WS_WO1); bf16* WG = (bf16*)(ws + WS_WG); bf16* WM13 = (bf16*)(ws + WS_WM13); bf16* WM2 = (bf16*)(ws + WS_WM2);
    bf16* XB = (bf16*)(ws + WS_XB); bf16* MEMB = (bf16*)(ws + WS_MEMB); bf16* ZG = (bf16*)(ws + WS_ZG); bf16* U = (bf16*)(ws + WS_U); bf16* QM0 = (bf16*)(ws + WS_QM0);
    bf16* MKV = (bf16*)(ws + WS_MKV); f32x2* AGG = (f32x2*)(ws + WS_AGG); bf16* CAT = (bf16*)(ws + WS_CAT); float* Y = (float*)(ws + WS_Y);
    unsigned char* H1F8 = ws + WS_QM0; bf16* H1 = (bf16*)(ws + WS_H1); bf16* H2 = (bf16*)(ws + WS_H2); bf16* H3 = (bf16*)(ws + WS_H3); bf16* HID = (bf16*)(ws + WS_HID);
    bf16* KB = (bf16*)(ws + WS_K); bf16* VB = (bf16*)(ws + WS_V); bf16* QD = (bf16*)(ws + WS_QD); bf16* QM1 = (bf16*)(ws + WS_QM1); float* STASH = (float*)(ws + WS_STASH);
    bf16* AG = (bf16*)(ws + WS_AG); bf16* HIDM = (bf16*)(ws + WS_HIDM); bf16* Y2 = (bf16*)(ws + WS_Y2);
    int* RTE = (int*)(ws + RT_E); float* RTG = (float*)(ws + RT_G); int* WCNT = (int*)(ws + RT_WCNT); int* STOK = (int*)(ws + RT_STOK); float* SGATE = (float*)(ws + RT_SGATE);
    int* TDEST = (int*)(ws + RT_TDEST); int* TILEE = (int*)(ws + RT_TILEE); int* META = (int*)(ws + RT_META);
    const float* ln_g = args.in[IN_LN_G]; const float* ln_b = args.in[IN_LN_B];

    PH_BEGIN(0) {
        LAS float* scr = (LAS float*)(lds + RING_OFF + wave * 16384);
        int base = 0;
        p0_job(args.in[IN_A_W_IN], D, DZ, WZ, 0, 0, base, gw, NGW, scr, lane);
        p0_job(args.in[IN_A_W_OUT], DCAT, D, WO0, 0, 0, base, gw, NGW, scr, lane);
        p0_job(args.in[IN_FFN_W13], D, 2 * FF, W13, 1, 0, base, gw, NGW, scr, lane);
        p0_job(args.in[IN_FFN_W2], FF, D, W2, 0, 0, base, gw, NGW, scr, lane);
        p0_job(args.in[IN_MEM_W_KV], D, D, WMKV, 0, 0, base, gw, NGW, scr, lane);
        p0_job(args.in[IN_MEM_W_KV] + (size_t)D * D, D, D, WMKV, 0, D, base, gw, NGW, scr, lane);
        p0_job(args.in[IN_W_KV], D, 2 * D, WKVQ, 0, 0, base, gw, NGW, scr, lane);
        p0_job(args.in[IN_B_W_Q], D, DCAT, WKVQ, 0, 2 * D, base, gw, NGW, scr, lane);
        p0_job(args.in[IN_B_W_OUT], DCAT, D, WO1, 0, 0, base, gw, NGW, scr, lane);
        for (int n = 0; n < 8; ++n) {
            p0_job(args.in[IN_A_W_RG] + (size_t)n * 16384, 128, 128, WG, 0, n * 256, base, gw, NGW, scr, lane);
            p0_job(args.in[IN_A_W_IG] + (size_t)n * 16384, 128, 128, WG, 0, n * 256 + 128, base, gw, NGW, scr, lane);
        }
        for (int e = 0; e < NEXP; ++e) {
            p0_job_f8(args.in[IN_MOE_W13] + (size_t)e * D * 2 * FF, D, 2 * FF, (unsigned char*)WM13 + (size_t)e * 2 * FF * D, 1, 0, WSC13, base, gw, NGW, scr, lane);
            p0_job_f8(args.in[IN_MOE_W2] + (size_t)e * FF * D, FF, D, (unsigned char*)WM2 + (size_t)e * D * FF, 0, 0, WSC2, base, gw, NGW, scr, lane);
        }
        const size_t gtid = (size_t)bx * 512 + tid, nth = (size_t)G * 512;
        p0_cvt_rows(args.in[IN_X], XB, (size_t)M * D / 8, gtid, nth);
        p0_cvt_rows(args.in[IN_MEM], MEMB, (size_t)MEMROWS * D / 8, gtid, nth);
    }
    SEAM(0);

    PH_BEGIN(1) {
        { pg8::Gemm g{XB, WZ, M, DZ, D, 0}; pg8::StaticOrder S; S.init(M, DZ, G, bx);
          pg8::EpiSegT<0> E{ws};
          pg8::gemm_phase<pg8::EpiSegT<0>, pg8::StaticOrder, true, true>(lds + RING_OFF, g, S, E); }
        { pg8::Gemm g{MEMB, WMKV, MEMROWS, 2 * D, D, 0}; pg8::StaticOrder S; S.init(MEMROWS, 2 * D, G, bx);
          pg8::EpiSegT<1> E{ws};
          pg8::gemm_phase<pg8::EpiSegT<1>, pg8::StaticOrder, true, true>(lds + RING_OFF, g, S, E); }
    }
    SEAM(1);

    PH_BEGIN(2) {
        bool first = true;
        for (int L = bx; L < 1024; L += G) { const int pair = L & 63, c = L >> 6; scan_unit(1, pair >> 3, pair & 7, c, first || (G & 63), U, ZG, CAT, WG, AGG,
                args.in[IN_A_CONV_W], args.in[IN_A_CONV_B], args.in[IN_A_B_RG], args.in[IN_A_B_IG], args.in[IN_A_LAMBDA], lds); first = false; }
        __syncthreads();
        for (int L = bx; L < 512; L += G) { const int b = L >> 6, hd = (L >> 4) & 3, qb = L & 15; const size_t row0 = (size_t)b * T + qb * 256 + wave * 32;
            f32x16 o[4];
            att::attn_core<128, 128, false>(QM0 + row0 * 512 + hd * 128, 512, MKV + (size_t)b * MEMT * 2 * D + hd * 128, 2 * D, MKV + (size_t)b * MEMT * 2 * D + 512 + hd * 128, 2 * D, 4, 0, 0.f, lds, o);
            att::store_o128(o, CAT + row0 * DCAT + D + hd * 128, DCAT, lds); }
    }
    SEAM(2);

    PH_BEGIN(3) {
        bool first = true;
        for (int L = bx; L < 1024; L += G) { const int pair = L & 63, c = L >> 6; scan_unit(2, pair >> 3, pair & 7, c, first || (G & 63), U, ZG, CAT, WG, AGG,
                args.in[IN_A_CONV_W], args.in[IN_A_CONV_B], args.in[IN_A_B_RG], args.in[IN_A_B_IG], args.in[IN_A_LAMBDA], lds); first = false; }
        __syncthreads();
    }
    SEAM(3);

    PH_BEGIN(4) { pg8::Gemm g{CAT, WO0, M, D, DCAT, 0}; pg8::StaticOrder S; S.init(M, D, G, bx); pg8::EpiF32 E{Y, D, 1.0f};
        pg8::gemm_phase<pg8::EpiF32, pg8::StaticOrder, true, true>(lds + RING_OFF, g, S, E); }
    SEAM(4);
    PH_BEGIN(5) { for (int m0 = gw * 4; m0 < M; m0 += NGW * 4) { f32x4 v[4][4]; ln_rows<4, true, false>(Y, args.in[IN_X], nullptr, nullptr, (size_t)m0, ln_g, ln_b, H1, nullptr, v, lane); } }
    SEAM(5);
    PH_BEGIN(6) { pg8::Gemm g{H1, W13, M, 2 * FF, D, 0}; pg8::StaticOrder S; S.init(M, 2 * FF, G, bx); pg8::EpiSwiGLU E{HID, FF};
        pg8::gemm_phase<pg8::EpiSwiGLU, pg8::StaticOrder, true, true>(lds + RING_OFF, g, S, E); }
    SEAM(6);
    PH_BEGIN(7) { pg8::Gemm g{HID, W2, M, D, FF, 0}; pg8::StaticOrder S; S.init(M, D, G, bx); pg8::EpiF32 E{Y, D, 1.0f};
        pg8::gemm_phase<pg8::EpiF32, pg8::StaticOrder, true, true>(lds + RING_OFF, g, S, E); }
    SEAM(7);
    PH_BEGIN(8) { for (int m0 = gw * 4; m0 < M; m0 += NGW * 4) { f32x4 v[4][4]; ln_rows<4, false, false>(Y, H1, nullptr, nullptr, (size_t)m0, ln_g + D, ln_b + D, H2, nullptr, v, lane); } }
    SEAM(8);
    PH_BEGIN(9) { pg8::Gemm g{H2, WKVQ, M, NKVQ, D, 0}; pg8::StaticOrder S; S.init(M, NKVQ, G, bx);
        pg8::EpiSegT<2> E{ws};
        pg8::gemm_phase<pg8::EpiSegT<2>, pg8::StaticOrder, true, true>(lds + RING_OFF, g, S, E); }
    SEAM(9);
    PH_BEGIN(10) {
        const float* lv = args.in[IN_B_LAMBDA];
        const float s1 = wave_sum(lv[lane] * lv[64 + lane]), s2 = wave_sum(lv[128 + lane] * lv[192 + lane]);
        const float lam = __expf(s1) - __expf(s2) + LAM_INIT;
        const int r32 = lane & 31, hi = lane >> 5;
        for (int L = bx; L < 1024; L += G) {
            const int i = L >> 8, w = L & 255, pair = w & 63, j = w >> 6, b = pair >> 3, h = pair & 7;
            const int qb = (i == 0) ? j : (i == 1) ? 7 - j : (i == 2) ? 8 + j : 15 - j;
            const size_t rowb = (size_t)b * T, row0 = rowb + qb * 256 + wave * 32;
            const float slope2 = exp2f(-(float)(h + 1)) * LOG2E;
            const int NT = (qb * 256 + 256) / 64, qpos0 = qb * 256 + wave * 32;
            f32x4* st = (f32x4*)(STASH + (size_t)(bx * NWAVES + wave) * 4096) + lane * 16;
            f32x16 o[4];
#ifndef T10_NOFIRST
            att::attn_core<64, 128, true>(QD + row0 * D + h * 128 + 64, D, KB + rowb * D + h * 128 + 64, D, VB + rowb * D + h * 128, D, NT, qpos0, slope2, lds, o);
#pragma unroll
            for (int d = 0; d < 4; ++d)
#pragma unroll
                for (int r4 = 0; r4 < 4; ++r4) st[d * 4 + r4] = (f32x4){o[d][4 * r4], o[d][4 * r4 + 1], o[d][4 * r4 + 2], o[d][4 * r4 + 3]};
#endif
            att::attn_core<64, 128, true>(QD + row0 * D + h * 128, D, KB + rowb * D + h * 128, D, VB + rowb * D + h * 128, D, NT, qpos0, slope2, lds, o);
            VM_WAIT();
#ifndef T10_NOCOMB
            float gsub[4];
#pragma unroll
            for (int d = 0; d < 4; ++d) gsub[d] = args.in[IN_B_SUBLN][32 * d + r32] * (1.0f - LAM_INIT);
#pragma unroll
            for (int r4 = 0; r4 < 4; ++r4) {
                f32x4 s1[4];
#pragma unroll
                for (int d = 0; d < 4; ++d) s1[d] = st[d * 4 + r4];
#pragma unroll
                for (int k = 0; k < 4; ++k) { const int r = 4 * r4 + k; float ss = 0.f;
#pragma unroll
                    for (int d = 0; d < 4; ++d) { const float x = o[d][r] - lam * s1[d][k]; o[d][r] = x; ss += x * x; }
                    ss += __shfl_xor(ss, 1); ss += __shfl_xor(ss, 2); ss += __shfl_xor(ss, 4); ss += __shfl_xor(ss, 8); ss += __shfl_xor(ss, 16);
                    const float rinv = 1.0f / sqrtf(ss * (1.0f / 128.0f) + LN_EPS);
#pragma unroll
                    for (int d = 0; d < 4; ++d) o[d][r] *= rinv * gsub[d]; }
            }
#endif
            att::store_o128(o, CAT + row0 * DCAT + h * 128, DCAT, lds);
        }
        for (int L = bx; L < 512; L += G) { const int b = L >> 6, hd = (L >> 4) & 3, qb = L & 15; const size_t row0 = (size_t)b * T + qb * 256 + wave * 32;
            f32x16 o[4];
            att::attn_core<128, 128, false>(QM1 + row0 * 512 + hd * 128, 512, MKV + (size_t)b * MEMT * 2 * D + D + hd * 128, 2 * D, MKV + (size_t)b * MEMT * 2 * D + D + 512 + hd * 128, 2 * D, 4, 0, 0.f, lds, o);
            att::store_o128(o, CAT + row0 * DCAT + D + hd * 128, DCAT, lds); }
        __syncthreads();
    }
    SEAM(10);
    PH_BEGIN(11) { pg8::Gemm g{CAT, WO1, M, D, DCAT, 0}; pg8::StaticOrder S; S.init(M, D, G, bx); pg8::EpiF32 E{Y, D, 1.0f};
        pg8::gemm_phase<pg8::EpiF32, pg8::StaticOrder, true, true>(lds + RING_OFF, g, S, E); }
    SEAM(11);
    PH_BEGIN(12) {
        LAS float* wr = (LAS float*)lds;
        for (int i = tid; i < D * NEXP / 4; i += 512) ((LAS f32x4*)wr)[i] = ((const f32x4*)args.in[IN_MOE_ROUTER])[i];
        __syncthreads();
        for (int slot = gw; slot < NSLOT; slot += NGW) {
            unsigned long long cnt64 = 0ull;
            for (int i4 = 0; i4 < 16; i4 += 4) { const int m0 = slot * 16 + i4; f32x4 v[4][4];
                ln_rows<4, false, false>(Y, H2, nullptr, nullptr, (size_t)m0, ln_g + 2 * D, ln_b + 2 * D, H3, nullptr, v, lane);
                float lg[4][8];
#pragma unroll
                for (int i = 0; i < 4; ++i)
#pragma unroll
                    for (int e = 0; e < 8; ++e) lg[i][e] = 0.f;
#pragma unroll
                for (int j = 0; j < 4; ++j)
#pragma unroll
                    for (int k = 0; k < 4; ++k) { const int col = 4 * lane + 256 * j + k; const f32x4 w0 = *(const LAS f32x4*)(wr + col * 8), w1 = *(const LAS f32x4*)(wr + col * 8 + 4);
#pragma unroll
                        for (int i = 0; i < 4; ++i) { const float x = v[i][j][k];
                            lg[i][0] += x * w0[0]; lg[i][1] += x * w0[1]; lg[i][2] += x * w0[2]; lg[i][3] += x * w0[3]; lg[i][4] += x * w1[0]; lg[i][5] += x * w1[1]; lg[i][6] += x * w1[2]; lg[i][7] += x * w1[3]; }
                        if (k == 3) __builtin_amdgcn_sched_barrier(0); }
#pragma unroll
                for (int o = 1; o < 64; o <<= 1)
#pragma unroll
                    for (int i = 0; i < 4; ++i)
#pragma unroll
                        for (int e = 0; e < 8; ++e) lg[i][e] += __shfl_xor(lg[i][e], o);
#pragma unroll
                for (int i = 0; i < 4; ++i) { const int m = m0 + i;
                    int e0 = 0; float v0 = lg[i][0];
#pragma unroll
                    for (int e = 1; e < 8; ++e) if (lg[i][e] > v0) { v0 = lg[i][e]; e0 = e; }
                    int e1 = -1; float v1 = -INFINITY;
#pragma unroll
                    for (int e = 0; e < 8; ++e) if (e != e0 && lg[i][e] > v1) { v1 = lg[i][e]; e1 = e; }
                    e0 = __builtin_amdgcn_readfirstlane(e0); e1 = __builtin_amdgcn_readfirstlane(e1);
                    const float g0 = 1.0f / (1.0f + __expf(v1 - v0));
                    if (lane == 0) { RTE[m] = e0 | (e1 << 8); RTG[2 * m] = g0; RTG[2 * m + 1] = 1.0f - g0; }
                    cnt64 += (1ull << (8 * e0)) + (1ull << (8 * e1)); }
            }
            if (lane < 8) WCNT[slot * 8 + lane] = (int)((cnt64 >> (8 * lane)) & 0xffull);
        }
        __syncthreads();
    }
    SEAM(12);
    PH_BEGIN(13) {
        LAS int* cnt = (LAS int*)lds; LAS int* part = cnt + NSLOT * 8; LAS int* meta = part + 512;
        for (int i = tid; i < NSLOT * 8; i += 512) cnt[i] = WCNT[i];
        __syncthreads();
        { const int e = tid & 7, j = tid >> 3; int s = 0; for (int k = 0; k < 32; ++k) s += cnt[(32 * j + k) * 8 + e]; part[j * 8 + e] = s; }
        __syncthreads();
        if (tid < 8) { int run = 0; for (int j = 0; j < 64; ++j) { const int t = part[j * 8 + tid]; part[j * 8 + tid] = run; run += t; } meta[tid] = run; }
        __syncthreads();
        if (tid == 0) { int ps = 0; for (int e = 0; e < 8; ++e) { meta[8 + e] = ps; ps += (meta[e] + 255) / 256 * 256; } meta[16] = ps / 256; }
        { const int e = tid & 7, j = tid >> 3; int run = part[j * 8 + e]; for (int k = 0; k < 32; ++k) { const int t = cnt[(32 * j + k) * 8 + e]; cnt[(32 * j + k) * 8 + e] = run; run += t; } }
        __syncthreads();
        if (bx == 0) { const int nt = meta[16]; if (tid == 0) META[0] = nt;
            for (int pm = tid; pm < 512; pm += 512) { int e = 7; for (int q = 7; q >= 0; --q) if (pm * 256 < meta[8 + q] + (meta[q] + 255) / 256 * 256) e = q; TILEE[pm] = (pm < nt) ? e : 0; } }
        for (int slot = gw; slot < NSLOT; slot += NGW) {
            unsigned long long lc = 0ull;
            for (int i = 0; i < 16; ++i) { const int m = slot * 16 + i; const int ee = __builtin_amdgcn_readfirstlane(RTE[m]);
#pragma unroll
                for (int k = 0; k < 2; ++k) { const int e = (ee >> (8 * k)) & 0xff; const int dest = meta[8 + e] + cnt[slot * 8 + e] + (int)((lc >> (8 * e)) & 0xffull); lc += 1ull << (8 * e);
                    if (lane == 0) { STOK[dest] = m; SGATE[dest] = RTG[2 * m + k]; TDEST[2 * m + k] = dest; }
                    const u32x4 a = *((const u32x4*)(H3 + (size_t)m * D) + 2 * lane), c2 = *((const u32x4*)(H3 + (size_t)m * D) + 2 * lane + 1);
                    u32x4 o8; o8.x = pg8::cvt4_fp8(bflo(a.x), bfhi(a.x), bflo(a.y), bfhi(a.y)); o8.y = pg8::cvt4_fp8(bflo(a.z), bfhi(a.z), bflo(a.w), bfhi(a.w));
                    o8.z = pg8::cvt4_fp8(bflo(c2.x), bfhi(c2.x), bflo(c2.y), bfhi(c2.y)); o8.w = pg8::cvt4_fp8(bflo(c2.z), bfhi(c2.z), bflo(c2.w), bfhi(c2.w));
                    *((u32x4*)((unsigned char*)AG + (size_t)dest * D) + lane) = o8; }
            }
        }
        __syncthreads();
    }
    SEAM(13);
    PH_BEGIN(14) { const int nt = __builtin_amdgcn_readfirstlane(META[0]);
        pg8::Gemm g{AG, WM13, nt * 256, 2 * FF, D / 2, (size_t)2 * FF * D}; pg8::GroupedOrder S; S.init(nt * 256, 2 * FF, G, bx); S.tile_e = TILEE; pg8::EpiSwiGLU8 E{(unsigned char*)HIDM, FF, 1.0f / WSC13, HSC};
        pg8::gemm_phase<pg8::EpiSwiGLU8, pg8::GroupedOrder, true, true, true>(lds + RING_OFF, g, S, E); }
    SEAM(14);
    PH_BEGIN(15) { const int nt = __builtin_amdgcn_readfirstlane(META[0]);
        pg8::Gemm g{HIDM, WM2, nt * 256, D, FF / 2, (size_t)D * FF}; pg8::GroupedOrder S; S.init(nt * 256, D, G, bx); S.tile_e = TILEE; pg8::EpiRowScale E{Y2, D, SGATE, 1.0f / (WSC2 * HSC)};
        pg8::gemm_phase<pg8::EpiRowScale, pg8::GroupedOrder, true, true, true>(lds + RING_OFF, g, S, E); }
    SEAM(15);
    PH_BEGIN(16) { for (int m0 = gw * 4; m0 < M; m0 += NGW * 4) { f32x4 v[4][4]; ln_rows<4, false, true>(nullptr, H3, Y2, TDEST, (size_t)m0, ln_g + 3 * D, ln_b + 3 * D, nullptr, args.out, v, lane); } }
#undef IN
#undef SEAM
}

#ifndef MK_ONE_LAUNCH
#define MK_ONE_LAUNCH 1
#endif
extern "C" void kernel_launch(void* const* d_in, const int* in_sizes, int n_in, void* d_out, int out_size, void* d_ws, size_t ws_size, hipStream_t stream) {
    static int grid = 0;
    if (grid == 0) {
        if (n_in != N_IN || in_sizes[0] != M * D || out_size != M * D || ws_size < WS_END) { fprintf(stderr, "kernel_launch: unexpected shapes (n_in %d, in0 %d, out %d, ws %zu < %zu)\n", n_in, n_in > 0 ? in_sizes[0] : -1, out_size, ws_size, (size_t)WS_END); grid = -1; return; }
        int dev = 0, cus = 0, per_cu = 0;
        if (hipGetDevice(&dev) != hipSuccess || hipDeviceGetAttribute(&cus, hipDeviceAttributeMultiprocessorCount, dev) != hipSuccess) { grid = -1; return; }
        if (hipFuncSetAttribute((const void*)yoco_fwd, hipFuncAttributeMaxDynamicSharedMemorySize, LDS_BYTES) != hipSuccess) { fprintf(stderr, "kernel_launch: hipFuncSetAttribute failed\n"); grid = -1; return; }
        if (hipOccupancyMaxActiveBlocksPerMultiprocessor(&per_cu, (const void*)yoco_fwd, NWAVES * 64, LDS_BYTES) != hipSuccess || per_cu < 1) fprintf(stderr, "kernel_launch: occupancy query says %d\n", per_cu);
        (void)hipGetLastError();
        grid = cus;
    }
    if (grid < 0) return;
    (void)hipMemsetAsync((char*)d_ws + WS_CTL, 0, CTL_ZERO_BYTES, stream);
    Args a{};
    for (int i = 0; i < N_IN; ++i) a.in[i] = (const float*)d_in[i];
    a.out = (float*)d_out; a.ws = (unsigned char*)d_ws;
#if MK_ONE_LAUNCH
    a.ph_lo = 0; a.ph_hi = N_PHASES;
    hipLaunchKernelGGL(yoco_fwd, dim3(grid), dim3(NWAVES * 64), LDS_BYTES, stream, a);
#else
    for (int p = 0; p < N_PHASES; ++p) { a.ph_lo = p; a.ph_hi = p + 1; hipLaunchKernelGGL(yoco_fwd, dim3(grid), dim3(NWAVES * 64), LDS_BYTES, stream, a); }
#endif
    const hipError_t le = hipPeekAtLastError();
    if (le != hipSuccess) fprintf(stderr, "kernel_launch: launch failed: %s\n", hipGetErrorName(le));
}
```
